# Optimizing an MI355X kernel written in HIP

```python
import math
import jax
import jax.numpy as jnp
from jax import lax
import numpy as np


D_MODEL = 1024
BATCH = 8
SEQ = 4096
DEPTH = 2

MEM_LEN = 256
EPS = 1e-6
N_BRANCH = 4
BRANCH_W = 256
CONV_W = 3
GLA_HEADS = 4
GLA_DK = 64
GLA_DV = 64
GLA_RANK = 16
GLA_TAU = 16.0
GLA_CHUNK = 64
S5_GROUP = 16
S5_GROUPS = BRANCH_W // S5_GROUP
S5_STATE = 64
S5_DT_MIN = 1e-3
S5_DT_MAX = 1e-1
DSA_HEADS = 4
DSA_HEAD_DIM = 64
IDX_HEADS = 8
IDX_DIM = 32
DSA_TOPK = 256
Q_BLOCK = 128
ROPE_THETA = 500000.0
ROPE_FRAC = 4
X_HEADS = 4
X_HEAD_DIM = 128
N_GROUPS = 4
EXPERTS_PER_GROUP = 4
N_EXPERTS = N_GROUPS * EXPERTS_PER_GROUP
TOPK_IN_GROUP = 2
D_FF_EXPERT = 512

IN_SPLITS = (
    BRANCH_W, BRANCH_W, BRANCH_W,
    GLA_HEADS * GLA_DK, GLA_HEADS * GLA_DK, GLA_HEADS * GLA_DV,
    GLA_HEADS * GLA_DV, GLA_RANK,
    BRANCH_W,
    DSA_HEADS * DSA_HEAD_DIM, DSA_HEAD_DIM, DSA_HEAD_DIM,
    IDX_HEADS * IDX_DIM, IDX_DIM, IDX_HEADS,
    N_BRANCH * D_MODEL,
)
D_IN = sum(IN_SPLITS)
IN_OFFSETS = tuple(sum(IN_SPLITS[:i + 1]) for i in range(len(IN_SPLITS) - 1))

kernel_name = 'hybrid_gated_conv_gla_s5_dsa_hmoe'


def rmsnorm(x, g):
    xf = x.astype(jnp.float32)
    y = xf * lax.rsqrt(jnp.mean(xf * xf, axis=-1, keepdims=True) + EPS)
    return (y * g.astype(jnp.float32)).astype(x.dtype)


def rope_partial(t, positions):
    dh = t.shape[-1]
    rd = dh // ROPE_FRAC
    half = rd // 2
    inv_freq = ROPE_THETA ** (-jnp.arange(half, dtype=jnp.float32) * (2.0 / rd))
    ang = positions.astype(jnp.float32)[:, :, None] * inv_freq
    cos = jnp.cos(ang)[:, :, None, :]
    sin = jnp.sin(ang)[:, :, None, :]
    t1 = t[..., :half].astype(jnp.float32)
    t2 = t[..., half:rd].astype(jnp.float32)
    rot = jnp.concatenate([t1 * cos - t2 * sin, t2 * cos + t1 * sin], axis=-1).astype(t.dtype)
    return jnp.concatenate([rot, t[..., rd:]], axis=-1)


def short_conv_mixer(h_in, b_gate, c_gate, conv_w, conv_b):
    u = c_gate * h_in
    y = lax.conv_general_dilated(
        u, conv_w[:, None, :], window_strides=(1,), padding=[(CONV_W - 1, 0)],
        dimension_numbers=('NWC', 'WIO', 'NWC'), feature_group_count=u.shape[-1])
    return b_gate * (y + conv_b)


def gla_mixer(q, k, v, r, a_low, a_up, a_b, g_norm):
    B, S, _ = q.shape
    H, dk, dv, C = GLA_HEADS, GLA_DK, GLA_DV, GLA_CHUNK
    N = S // C
    f32 = jnp.float32
    log_a = jax.nn.log_sigmoid((a_low @ a_up).astype(f32) + a_b.astype(f32)) / GLA_TAU
    shp = lambda t, d: t.astype(f32).reshape(B, N, C, H, d)
    qc = shp(q, dk) * (dk ** -0.5)
    kc = shp(k, dk)
    vc = shp(v, dv)
    bcum = jnp.cumsum(shp(log_a, dk), axis=2)
    blast = bcum[:, :, -1:]
    q_dec = qc * jnp.exp(bcum)
    k_inv = kc * jnp.exp(-bcum)
    k_end = kc * jnp.exp(blast - bcum)
    causal = jnp.tril(jnp.ones((C, C), dtype=bool))
    att = jnp.einsum('bnihd,bnjhd->bnhij', q_dec, k_inv)
    att = jnp.where(causal, att, 0.0)
    o_intra = jnp.einsum('bnhij,bnjhe->bnihe', att, vc)

    def step(state, inp):
        qd, ke, vv, dec = inp
        o = jnp.einsum('bihd,bhde->bihe', qd, state)
        state = state * dec[..., None] + jnp.einsum('bjhd,bjhe->bhde', ke, vv)
        return state, o

    xs = (jnp.moveaxis(q_dec, 1, 0), jnp.moveaxis(k_end, 1, 0), jnp.moveaxis(vc, 1, 0),
          jnp.moveaxis(jnp.exp(blast[:, :, 0]), 1, 0))
    state0 = jnp.zeros((B, H, dk, dv), f32)
    _, o_inter = lax.scan(step, state0, xs)
    o = (o_intra + jnp.moveaxis(o_inter, 0, 1)).reshape(B, S, H, dv)
    o = o * lax.rsqrt(jnp.mean(o * o, axis=-1, keepdims=True) + EPS)
    o = o.reshape(B, S, H * dv) * g_norm.astype(f32) * jax.nn.silu(r.astype(f32))
    return o.astype(q.dtype)


def s5_mixer(u, lam_re, lam_im, log_dt, b_re, b_im, c_re, c_im, d_skip, w_glu, b_glu):
    B, S, _ = u.shape
    G, P = S5_GROUPS, S5_STATE
    f32 = jnp.float32
    uf = u.astype(f32).reshape(B, S, G, S5_GROUP)
    lam_re = lam_re.astype(f32)
    lam_im = lam_im.astype(f32)
    dt = jnp.exp(log_dt.astype(f32))[:, None]
    mag = jnp.exp(lam_re * dt)
    lb_re = mag * jnp.cos(lam_im * dt)
    lb_im = mag * jnp.sin(lam_im * dt)
    den = lam_re * lam_re + lam_im * lam_im
    f_re = ((lb_re - 1.0) * lam_re + lb_im * lam_im) / den
    f_im = (lb_im * lam_re - (lb_re - 1.0) * lam_im) / den
    b_re = b_re.astype(f32)
    b_im = b_im.astype(f32)
    bb_re = f_re[..., None] * b_re - f_im[..., None] * b_im
    bb_im = f_re[..., None] * b_im + f_im[..., None] * b_re
    bu_re = jnp.einsum('bsgc,gpc->bsgp', uf, bb_re)
    bu_im = jnp.einsum('bsgc,gpc->bsgp', uf, bb_im)
    a_re = jnp.broadcast_to(lb_re, bu_re.shape)
    a_im = jnp.broadcast_to(lb_im, bu_im.shape)

    def combine(e1, e2):
        a1r, a1i, b1r, b1i = e1
        a2r, a2i, b2r, b2i = e2
        return (a2r * a1r - a2i * a1i, a2r * a1i + a2i * a1r,
                a2r * b1r - a2i * b1i + b2r, a2r * b1i + a2i * b1r + b2i)

    _, _, x_re, x_im = lax.associative_scan(combine, (a_re, a_im, bu_re, bu_im), axis=1)
    y = (jnp.einsum('bsgp,gcp->bsgc', x_re, c_re.astype(f32))
         - jnp.einsum('bsgp,gcp->bsgc', x_im, c_im.astype(f32)))
    y = y.reshape(B, S, G * S5_GROUP) + d_skip.astype(f32) * uf.reshape(B, S, G * S5_GROUP)
    y = jax.nn.gelu(y)
    y = y * jax.nn.sigmoid(y @ w_glu.astype(f32) + b_glu.astype(f32))
    return y.astype(u.dtype)


def dsa_mixer(q, k, v, qi, ki, wi, positions):
    B, S, _ = q.shape
    f32 = jnp.float32
    q = rope_partial(q.reshape(B, S, DSA_HEADS, DSA_HEAD_DIM), positions)
    k = rope_partial(k[:, :, None, :], positions)[:, :, 0]
    qi = rope_partial(qi.reshape(B, S, IDX_HEADS, IDX_DIM), positions)
    ki = rope_partial(ki[:, :, None, :], positions)[:, :, 0]
    wi = wi * ((IDX_HEADS ** -0.5) * (IDX_DIM ** -0.5))
    topk = min(DSA_TOPK, S // 4)
    nb = S // Q_BLOCK
    ki32 = ki.astype(f32)

    def blockify(t):
        return jnp.moveaxis(t.reshape((B, nb, Q_BLOCK) + t.shape[2:]), 1, 0)

    def one_block(args):
        qb, qib, wib, start = args
        t_idx = start + jnp.arange(Q_BLOCK)
        iscore = jnp.einsum('bqhd,bsd->bqhs', qib.astype(f32), ki32)
        iscore = jnp.einsum('bqhs,bqh->bqs', jax.nn.relu(iscore), wib.astype(f32))
        causal = jnp.arange(S)[None, :] <= t_idx[:, None]
        iscore = jnp.where(causal[None], iscore, -jnp.inf)
        _, sel = lax.top_k(iscore, topk)
        valid = sel <= t_idx[None, :, None]
        k_sel = jax.vmap(lambda kk, ii: kk[ii])(k, sel)
        v_sel = jax.vmap(lambda vv, ii: vv[ii])(v, sel)
        logits = jnp.einsum('bqhd,bqkd->bqhk', qb.astype(f32), k_sel.astype(f32)) * (DSA_HEAD_DIM ** -0.5)
        logits = jnp.where(valid[:, :, None, :], logits, -jnp.inf)
        p = jax.nn.softmax(logits, axis=-1)
        o = jnp.einsum('bqhk,bqkd->bqhd', p, v_sel.astype(f32))
        return o.astype(qb.dtype)

    starts = jnp.arange(nb, dtype=jnp.int32) * Q_BLOCK
    out = lax.map(one_block, (blockify(q), blockify(qi), blockify(wi), starts))
    return jnp.moveaxis(out, 0, 1).reshape(B, S, DSA_HEADS * DSA_HEAD_DIM)


def mem_cross_attn(h, memn, w_q, w_kv, w_o):
    B, S, _ = h.shape
    M = memn.shape[1]
    q = (h @ w_q).reshape(B, S, X_HEADS, X_HEAD_DIM)
    k, v = jnp.split(memn @ w_kv, 2, axis=-1)
    k = k.reshape(B, M, X_HEADS, X_HEAD_DIM)
    v = v.reshape(B, M, X_HEADS, X_HEAD_DIM)
    logits = jnp.einsum('bshd,bmhd->bhsm', q, k).astype(jnp.float32) * (X_HEAD_DIM ** -0.5)
    p = jax.nn.softmax(logits, axis=-1).astype(v.dtype)
    o = jnp.einsum('bhsm,bmhd->bshd', p, v).reshape(B, S, X_HEADS * X_HEAD_DIM)
    return o @ w_o


def hier_moe(h, w_rg, b_rg, w_re, b_re, w_gate, w_up, w_down):
    B, S, _ = h.shape
    f32 = jnp.float32
    g_prob = jax.nn.softmax((h @ w_rg).astype(f32) + b_rg.astype(f32), axis=-1)
    p_g, g_sel = lax.top_k(g_prob, 1)
    g_onehot = jax.nn.one_hot(g_sel[..., 0], N_GROUPS, dtype=f32)
    e_logits = ((h @ w_re).astype(f32) + b_re.astype(f32)).reshape(B, S, N_GROUPS, EXPERTS_PER_GROUP)
    e_prob = jax.nn.softmax(jnp.einsum('bsge,bsg->bse', e_logits, g_onehot), axis=-1)
    top_p, top_i = lax.top_k(e_prob, TOPK_IN_GROUP)
    top_p = top_p / jnp.sum(top_p, axis=-1, keepdims=True)
    expert_id = g_sel * EXPERTS_PER_GROUP + top_i
    combine = jnp.einsum('bske,bsk->bse', jax.nn.one_hot(expert_id, N_EXPERTS, dtype=f32),
                         p_g * top_p).astype(h.dtype)
    out = jnp.zeros_like(h)
    for e in range(N_EXPERTS):
        he = jax.nn.silu(h @ w_gate[e]) * (h @ w_up[e])
        out = out + combine[..., e:e + 1] * (he @ w_down[e])
    return out


def setup_inputs(seed: int = 0) -> dict:
    key = jax.random.key(seed)
    ks = iter(jax.random.split(key, 48))
    f32 = jnp.float32
    L, D, W = DEPTH, D_MODEL, BRANCH_W
    G, P = S5_GROUPS, S5_STATE
    nrm = lambda shape, scale: jax.random.normal(next(ks), shape, f32) * scale
    gain = lambda shape: 1.0 + nrm(shape, 0.02)
    x = nrm((BATCH, SEQ, D), 1.0)
    mem = nrm((BATCH, MEM_LEN, D), 1.0)
    positions = (jax.random.randint(next(ks), (BATCH, 1), 0, 1024)
                 + jnp.arange(SEQ)[None, :]).astype(jnp.int32)
    n_idx = jnp.arange(P, dtype=f32)
    return {
        'x': x,
        'mem': mem,
        'positions': positions,
        'norm_mix': gain((L, D)),
        'w_in': nrm((L, D, D_IN), D ** -0.5),
        'conv_w': nrm((L, CONV_W, W), CONV_W ** -0.5),
        'conv_b': nrm((L, W), 0.02),
        'gla_a_up': nrm((L, GLA_RANK, GLA_HEADS * GLA_DK), GLA_RANK ** -0.5),
        'gla_a_b': nrm((L, GLA_HEADS * GLA_DK), 0.1),
        'gla_norm': gain((L, GLA_HEADS * GLA_DV)),
        's5_lambda_re': -0.5 + nrm((L, G, P), 0.01),
        's5_lambda_im': math.pi * n_idx + nrm((L, G, P), 0.01),
        's5_log_dt': jax.random.uniform(next(ks), (L, G), f32, math.log(S5_DT_MIN), math.log(S5_DT_MAX)),
        's5_b_re': nrm((L, G, P, S5_GROUP), (2.0 * S5_GROUP) ** -0.5),
        's5_b_im': nrm((L, G, P, S5_GROUP), (2.0 * S5_GROUP) ** -0.5),
        's5_c_re': nrm((L, G, S5_GROUP, P), (2.0 * P) ** -0.5),
        's5_c_im': nrm((L, G, S5_GROUP, P), (2.0 * P) ** -0.5),
        's5_d': nrm((L, W), 1.0),
        's5_w_glu': nrm((L, W, W), W ** -0.5),
        's5_b_glu': nrm((L, W), 0.02),
        'w_branch': nrm((L, N_BRANCH, W, D), W ** -0.5),
        'w_out': nrm((L, D, D), D ** -0.5),
        'norm_cross': gain((L, D)),
        'w_cq': nrm((L, D, X_HEADS * X_HEAD_DIM), D ** -0.5),
        'w_ckv': nrm((L, D, 2 * X_HEADS * X_HEAD_DIM), D ** -0.5),
        'w_co': nrm((L, X_HEADS * X_HEAD_DIM, D), (X_HEADS * X_HEAD_DIM) ** -0.5),
        'norm_ffn': gain((L, D)),
        'w_route_group': nrm((L, D, N_GROUPS), D ** -0.5),
        'b_route_group': nrm((L, N_GROUPS), 0.01),
        'w_route_expert': nrm((L, D, N_EXPERTS), D ** -0.5),
        'b_route_expert': nrm((L, N_EXPERTS), 0.01),
        'w_e_gate': nrm((L, N_EXPERTS, D, D_FF_EXPERT), D ** -0.5),
        'w_e_up': nrm((L, N_EXPERTS, D, D_FF_EXPERT), D ** -0.5),
        'w_e_down': nrm((L, N_EXPERTS, D_FF_EXPERT, D), D_FF_EXPERT ** -0.5),
        'norm_mem': gain((D,)),
        'norm_final': gain((D,)),
    }


def reference(x, mem, positions, norm_mix, w_in, conv_w, conv_b, gla_a_up, gla_a_b, gla_norm,
              s5_lambda_re, s5_lambda_im, s5_log_dt, s5_b_re, s5_b_im, s5_c_re, s5_c_im, s5_d,
              s5_w_glu, s5_b_glu, w_branch, w_out, norm_cross, w_cq, w_ckv, w_co, norm_ffn,
              w_route_group, b_route_group, w_route_expert, b_route_expert, w_e_gate, w_e_up,
              w_e_down, norm_mem, norm_final):
    memn = rmsnorm(mem, norm_mem)
    for l in range(DEPTH):
        h = rmsnorm(x, norm_mix[l])
        (c_h, c_b, c_c, g_q, g_k, g_v, g_r, g_a, s_u,
         d_q, d_k, d_v, i_q, i_k, i_w, gates) = jnp.split(h @ w_in[l], IN_OFFSETS, axis=-1)
        y_a = short_conv_mixer(c_h, c_b, c_c, conv_w[l], conv_b[l])
        y_b = gla_mixer(g_q, g_k, g_v, g_r, g_a, gla_a_up[l], gla_a_b[l], gla_norm[l])
        y_c = s5_mixer(s_u, s5_lambda_re[l], s5_lambda_im[l], s5_log_dt[l], s5_b_re[l], s5_b_im[l],
                       s5_c_re[l], s5_c_im[l], s5_d[l], s5_w_glu[l], s5_b_glu[l])
        y_d = dsa_mixer(d_q, d_k, d_v, i_q, i_k, i_w, positions)
        gate_parts = jnp.split(gates, N_BRANCH, axis=-1)
        branches = (y_a, y_b, y_c, y_d)
        merged = jnp.zeros_like(x)
        for i in range(N_BRANCH):
            merged = merged + jax.nn.sigmoid(gate_parts[i]) * (branches[i] @ w_branch[l, i])
        x = x + merged @ w_out[l]
        x = x + mem_cross_attn(rmsnorm(x, norm_cross[l]), memn, w_cq[l], w_ckv[l], w_co[l])
        x = x + hier_moe(rmsnorm(x, norm_ffn[l]), w_route_group[l], b_route_group[l],
                         w_route_expert[l], b_route_expert[l], w_e_gate[l], w_e_up[l], w_e_down[l])
    return rmsnorm(x, norm_final)
```

```cpp
#include <hip/hip_runtime.h>
#include <cstdio>
#include <cstdint>

#define GAS __attribute__((address_space(1)))
#define LAS __attribute__((address_space(3)))
typedef unsigned short bf16;
typedef short bf16x8 __attribute__((ext_vector_type(8)));
typedef float f32x4 __attribute__((ext_vector_type(4)));
typedef float f32x16 __attribute__((ext_vector_type(16)));
typedef float f32x2 __attribute__((ext_vector_type(2)));
typedef unsigned u32x4 __attribute__((ext_vector_type(4)));
typedef unsigned u32x2 __attribute__((ext_vector_type(2)));

constexpr int NWAVES = 8, NTHR = 512;
constexpr int BATCH = 8, SEQ = 4096, T = BATCH * SEQ, D = 1024, DEPTH = 2, MEMLEN = 256, MROWS = BATCH * MEMLEN;
constexpr int D_IN = 6840, NPROJ = 2816, NGATE = 4096, NIN = NPROJ + NGATE;
constexpr int C_CH = 0, C_CB = 256, C_CC = 512, C_GQ = 768, C_GK = 1024, C_GV = 1280, C_GR = 1536, C_SU = 1792, C_DQ = 2048, C_IQ = 2304,
              C_DK = 2560, C_DV = 2624, C_IK = 2688, C_IW = 2720, C_GA = 2736, C_IL = 2752;
#define POFF(t, col) (((size_t)((col) >> 8) * T + (size_t)(t)) * 256 + ((col) & 255))
constexpr int NEXP = 16, DFF = 512;
constexpr int MOE_ROWS = 2 * T + NEXP * 256;
constexpr float EPS = 1e-6f;

constexpr size_t MiB = 1u << 20;
constexpr size_t WS_CTL = 0, CTL_ZERO_BYTES = 1 * MiB;
constexpr size_t WS_TOKPOS = 1 * MiB;
constexpr size_t WS_TOKW = WS_TOKPOS + 256 * 1024;
constexpr size_t WS_TILEE = WS_TOKW + 256 * 1024;
constexpr size_t WS_LAML = WS_TILEE + 4096;
constexpr size_t WS_GDEC = 2 * MiB;
constexpr size_t WS_MEMN = 3 * MiB;
constexpr size_t WS_K8 = WS_MEMN;
constexpr size_t WS_V8 = WS_MEMN + 2 * MiB;
constexpr size_t WS_ROWMAP = WS_MEMN; constexpr int CAPE = 32768;
constexpr size_t WS_KV = 7 * MiB;
constexpr size_t WS_WNM = 15 * MiB;
constexpr size_t WN_IN = 0, WN_BR = WN_IN + (size_t)NIN * 1024 * 2, WN_OUT = WN_BR + 2 * MiB, WN_CQ = WN_OUT + 2 * MiB, WN_CKV = WN_CQ + 1 * MiB,
                 WN_CO = WN_CKV + 2 * MiB, WN_GLU = WN_CO + 1 * MiB, WN_S5E = WN_GLU + 128 * 1024, WN_S5B = WN_S5E + 1 * MiB, WN_LAYER = WN_S5B + 3 * MiB;
static_assert(WN_LAYER == 26869760, "weights per layer");
constexpr size_t WS_WMOE = 67 * MiB;
constexpr size_t WM_GU = 0, WM_DN = 32 * MiB;
constexpr size_t WS_GSLOC = WS_WMOE, WS_XE = WS_WMOE + 32 * MiB;
constexpr size_t WS_H8 = WS_WMOE;
constexpr size_t WS_HY = 115 * MiB;
constexpr size_t WS_GATES = 179 * MiB;
constexpr size_t WS_HE = WS_GATES;
constexpr size_t WS_H8F = WS_GATES + 96 * MiB;
constexpr size_t WS_PROJ = 307 * MiB;
constexpr size_t WS_MERGED = WS_PROJ, WS_Q = WS_PROJ, WS_O = WS_PROJ + 32 * MiB, WS_HS = WS_PROJ, WS_OB = WS_PROJ;
constexpr size_t WS_XP = 483 * MiB;
constexpr size_t WS_SSQ = WS_XP;
constexpr size_t WS_YPRE = 491 * MiB;
constexpr size_t WS_END = 512 * MiB;
static_assert(WS_WNM + 2 * WN_LAYER <= WS_WMOE && WS_PROJ + (size_t)T * NPROJ * 2 <= WS_XP && WS_YPRE + (size_t)T * 256 * 2 <= WS_END && (size_t)MOE_ROWS * 1024 * 2 <= 176 * MiB && (size_t)MOE_ROWS * 512 * 2 <= 128 * MiB, "ws map");
constexpr int CW_BAR = 4096;
constexpr int CW_DSAQ = 16384;
constexpr int CW_MOECNT = 8192;

constexpr int LDS_BYTES = 155648;
constexpr int MISC_OFF = LDS_BYTES - 512;

__device__ __forceinline__ float bf2f(unsigned b) { return __uint_as_float(b << 16); }
__device__ __forceinline__ void lds_barrier() { asm volatile("s_waitcnt lgkmcnt(0)" ::: "memory"); __builtin_amdgcn_s_barrier(); asm volatile("" ::: "memory"); }
__device__ __forceinline__ float bflo(unsigned w) { return __uint_as_float(w << 16); }
__device__ __forceinline__ float bfhi(unsigned w) { return __uint_as_float(w & 0xffff0000u); }
__device__ __forceinline__ unsigned f2bf(float f) { unsigned u = __float_as_uint(f); return (u + 0x7fffu + ((u >> 16) & 1u)) >> 16; }
__device__ __forceinline__ unsigned pk2(float lo, float hi) { return f2bf(lo) | (f2bf(hi) << 16); }
__device__ __forceinline__ float wave_sum(float v) {
#pragma unroll
    for (int o = 1; o < 64; o <<= 1) v += __shfl_xor(v, o);
    return v;
}
__device__ __forceinline__ float wave_max(float v) {
#pragma unroll
    for (int o = 1; o < 64; o <<= 1) v = fmaxf(v, __shfl_xor(v, o));
    return v;
}
__device__ __forceinline__ float sigmoidf_(float x) { return __builtin_amdgcn_rcpf(1.f + __expf(-x)); }

#define XB_TMO      128
#define XB_XCNT(j)  (256  + 64 * (j))
#define XB_XSUB(j)  (1280 + 64 * (j))
#define XB_XGEN(j)  (2304 + 64 * (j))
#define XB_TOP      3328
#define XB_TOPGEN   3392
#define XCD_BAR_WORDS 3456
#define XB_SPIN_CAP (1u << 18)
__device__ __forceinline__ unsigned xb_ld(unsigned* p)              { return __hip_atomic_load(p, __ATOMIC_RELAXED, __HIP_MEMORY_SCOPE_AGENT); }
__device__ __forceinline__ unsigned xb_add(unsigned* p, unsigned v) { return __hip_atomic_fetch_add(p, v, __ATOMIC_RELAXED, __HIP_MEMORY_SCOPE_AGENT); }
__device__ __forceinline__ unsigned xb_xcc_id() { return (unsigned)__builtin_amdgcn_s_getreg((3 << 11) | 20) & 0xFu; }
#define XB_SPIN(cond, bar) do { unsigned _sp = 0; while (cond) { __builtin_amdgcn_s_sleep(1); \
    if ((++_sp & 255u) == 0u) { if (xb_ld(&(bar)[XB_TMO])) break; if (_sp > XB_SPIN_CAP) { atomicAdd(&(bar)[XB_TMO], 1u); break; } } } } while (0)
struct XcdBarrier { unsigned* bar; unsigned x; volatile LAS unsigned* st; };
__device__ __forceinline__ XcdBarrier xcd_barrier_post(unsigned* bar, volatile LAS unsigned* st, int tid) {
    XcdBarrier b; b.bar = bar; b.x = xb_xcc_id(); b.st = st;
    if (tid == 0) (void)xb_add(&bar[XB_XCNT(b.x)], 1u);
    return b;
}
__device__ __forceinline__ unsigned xcd_barrier_complete(unsigned* bar, unsigned x) {
    const unsigned G = gridDim.x * gridDim.y * gridDim.z;
    unsigned sum, cnt, mine, sp = 0u;
    for (;;) {
        sum = 0u; cnt = 0u;
#pragma unroll 1
        for (unsigned j = 0; j < 16; ++j) { const unsigned c = xb_ld(&bar[XB_XCNT(j)]); sum += c; cnt += (c > 0u) ? 1u : 0u; }
        mine = xb_ld(&bar[XB_XCNT(x)]);
        if (sum == G) break;
        __builtin_amdgcn_s_sleep(1);
        if ((++sp & 255u) == 0u) { if (xb_ld(&bar[XB_TMO])) break; if (sp > XB_SPIN_CAP) { atomicAdd(&bar[XB_TMO], 1u); break; } }
    }
    const unsigned nloc = mine > 0u ? mine : 1u, nx = cnt > 0u ? cnt : 1u;
    return nloc | (nx << 16);
}
__device__ __forceinline__ void xcd_barrier(const XcdBarrier& b, int tid) {
    asm volatile("s_waitcnt vmcnt(0)" ::: "memory");
    __syncthreads();
    if (tid == 0) {
        unsigned* bar = b.bar;
        __builtin_amdgcn_s_waitcnt(0);
        unsigned nloc = b.st[0], nx = b.st[1];
        if (nloc == 0u) { const unsigned r = xcd_barrier_complete(bar, b.x); nloc = r & 0xffffu; nx = r >> 16; b.st[0] = nloc; b.st[1] = nx; }
        const unsigned old = xb_add(&bar[XB_XSUB(b.x)], 1u);
        const unsigned gen = old / nloc;
        if (old + 1u == (gen + 1u) * nloc) {
            __builtin_amdgcn_fence(__ATOMIC_RELEASE, "agent");
            asm volatile("s_waitcnt vmcnt(0)" ::: "memory");
            const unsigned og = xb_add(&bar[XB_TOP], 1u);
            const unsigned tg = og / nx;
            if (og + 1u == (tg + 1u) * nx) xb_add(&bar[XB_TOPGEN], 1u);
            else XB_SPIN(xb_ld(&bar[XB_TOPGEN]) == tg, bar);
            __builtin_amdgcn_fence(__ATOMIC_ACQUIRE, "agent");
            xb_add(&bar[XB_XGEN(b.x)], 1u);
            asm volatile("s_waitcnt vmcnt(0)" ::: "memory");
        } else {
            XB_SPIN(xb_ld(&bar[XB_XGEN(b.x)]) == gen, bar);
            __builtin_amdgcn_fence(__ATOMIC_ACQUIRE, "agent");
            asm volatile("s_waitcnt vmcnt(0)" ::: "memory");
        }
    }
    __syncthreads();
}

#ifndef GEMM_ALIGN
#define GEMM_ALIGN 1
#endif
namespace pg8 {
constexpr int BM = 256, BK = 64, HALF = 128, HTB = HALF * BK * 2, STAGE_BYTES = 8 * HTB, NXCD = 8, WGM = 8;
__host__ __device__ __forceinline__ int lds_byte(int r, int c) { const int st = (r >> 4) * 2 + (c >> 5), rr = r & 15, cc = c & 31, ob = rr * 64 + cc * 2; return st * 1024 + (ob ^ (((ob >> 9) & 1) << 5)); }
__host__ __device__ __forceinline__ void stage_rc(int b, int& R, int& C) { const int st = b / 1024, sb = b % 1024, swz = sb ^ (((sb >> 9) & 1) << 5); R = (st >> 1) * 16 + swz / 64; C = (st & 1) * 32 + (swz % 64) / 2; }
__host__ __device__ __forceinline__ int perm32(int rho) { const int n = rho >> 4, i = rho & 15; return 8 * (i >> 2) + 4 * n + (i & 3); }

struct Unit { const char* A; const char* B; int pm, pn, aux; const int* amap; int avalid; };

__device__ __forceinline__ void tile_of(int L, int nM, int nN, int& pm, int& pn) {
    const int nwg = nM * nN; int wgid = L;
    { const int q = nwg / NXCD, r = nwg % NXCD, xcd = wgid % NXCD, off = wgid / NXCD; wgid = (xcd < r ? xcd * (q + 1) : r * (q + 1) + (xcd - r) * q) + off; }
    const int nig = WGM * nN, gid = wgid / nig, fm = gid * WGM, gsz = (nM - fm) < WGM ? (nM - fm) : WGM;
    pm = fm + ((wgid % nig) % gsz); pn = (wgid % nig) / gsz;
}
struct Sched2D {
    static constexpr bool GATHER = false;
    const char* A; const char* B; size_t atile, btile; int nM, nN, G, c;
    __device__ __forceinline__ bool next(int i, Unit& u) const {
        const long L = (long)i * G + c; if (L >= (long)nM * nN) return false;
        int pm, pn; tile_of((int)L, nM, nN, pm, pn);
        u.A = A + (size_t)pm * atile; u.B = B + (size_t)pn * btile; u.pm = pm; u.pn = pn; u.aux = 0; u.amap = nullptr; u.avalid = 0; return true;
    }
};
struct Sched2DSplit {
    static constexpr bool GATHER = false;
    const char* A; const char* B; size_t atile, btile; int nM, nN, G, c, nlo;
    __device__ __forceinline__ bool next(int i, Unit& u) const {
        const int half = G >> 1; long L;
        if (c < half) { if (i >= nlo) return false; L = (long)i * half + c; } else L = (long)nlo * half + (long)i * (G - half) + (c - half);
        if (L >= (long)nM * nN) return false;
        int pm, pn; tile_of((int)L, nM, nN, pm, pn);
        u.A = A + (size_t)pm * atile; u.B = B + (size_t)pn * btile; u.pm = pm; u.pn = pn; u.aux = 0; u.amap = nullptr; u.avalid = 0; return true;
    }
};
struct SchedBranch {
    static constexpr bool GATHER = false;
    const char* A; const char* B; int nM, nN, G, c;
    __device__ __forceinline__ bool next(int i, Unit& u) const {
        const long L = (long)(i >> 2) * G + c; if (L >= (long)nM * nN) return false;
        int pm, pn; tile_of((int)L, nM, nN, pm, pn); const int sub = i & 3;
        u.A = A + (size_t)pm * (256 * 1024 * 2) + sub * 512; u.B = B + (size_t)pn * (256 * 1024 * 2) + sub * 512; u.pm = pm; u.pn = pn; u.aux = sub; u.amap = nullptr; u.avalid = 0; return true;
    }
};
template <bool GATHER_>
struct SchedMoe {
    static constexpr bool GATHER = GATHER_;
    const char* A; const char* B; size_t atile, bexp, btile; LAS const int* tb; const int* rowmap; int nN, G, c;
    __device__ __forceinline__ bool next(int i, Unit& u) const {
        const long L = (long)i * G + c; if (L >= (long)__builtin_amdgcn_readfirstlane(tb[16]) * nN) return false;
        const int pm = (int)(L / nN), pn = (int)(L % nN);
        int e = 0, t0 = 0;
#pragma unroll
        for (int q = 1; q < 16; ++q) { const int tq = __builtin_amdgcn_readfirstlane(tb[q]); if (pm >= tq) { e = q; t0 = tq; } }
        const int ti = pm - t0;
        u.A = GATHER_ ? A : A + (size_t)pm * atile; u.B = B + (size_t)e * bexp + (size_t)pn * btile; u.pm = pm; u.pn = pn; u.aux = e;
        u.amap = rowmap + (size_t)e * CAPE + ti * 256; const int left = __builtin_amdgcn_readfirstlane(tb[17 + e]) - ti * 256; u.avalid = left < 256 ? left : 256; return true;
    }
};

__device__ __forceinline__ unsigned cvt_pk_bf16(float lo, float hi) { unsigned r; asm volatile("v_cvt_pk_bf16_f32 %0, %1, %2" : "=v"(r) : "v"(lo), "v"(hi)); return r; }

typedef f32x4 Acc[2][2][4][2];
typedef int i32x4_ __attribute__((ext_vector_type(4))); typedef int i32x8_ __attribute__((ext_vector_type(8)));

struct EpiBf16 {
    static constexpr bool PERM = true;
    bf16* O; int ldc;
    __device__ __forceinline__ bool operator()(Acc& acc, const Unit& u, int wr, int wc, int fr, int fq) const {
        const int row0 = u.pm * BM + wr * 64 + fr, col0 = u.pn * BM + wc * 32 + 8 * fq;
#pragma unroll
        for (int ai = 0; ai < 2; ++ai)
#pragma unroll
            for (int m = 0; m < 4; ++m) { bf16* rowp = O + (size_t)(row0 + ai * HALF + m * 16) * ldc + col0;
#pragma unroll
                for (int bj = 0; bj < 2; ++bj) { const f32x4 v0 = acc[ai][bj][m][0], v1 = acc[ai][bj][m][1];
                    u32x4 w; w.x = cvt_pk_bf16(v0[0], v0[1]); w.y = cvt_pk_bf16(v0[2], v0[3]); w.z = cvt_pk_bf16(v1[0], v1[1]); w.w = cvt_pk_bf16(v1[2], v1[3]);
                    *(u32x4*)(rowp + bj * HALF) = w; } }
        return false;
    }
};
__device__ __forceinline__ unsigned q8x4(f32x4 v) {
    unsigned w = 0u;
#pragma unroll
    for (int j = 0; j < 4; ++j) { const float s = fmaxf(sigmoidf_(v[j]) * 255.f, 1.f); w = __builtin_amdgcn_cvt_pk_u8_f32(s, j, w); }
    return w;
}
struct EpiInProj {
    static constexpr bool PERM = true;
    bf16* P; unsigned char* Gt;
    __device__ __forceinline__ bool operator()(Acc& acc, const Unit& u, int wr, int wc, int fr, int fq) const {
        const int row0 = u.pm * BM + wr * 64 + fr;
        if (u.pn < 11) {
            const int col0 = wc * 32 + 8 * fq;
#pragma unroll
            for (int ai = 0; ai < 2; ++ai)
#pragma unroll
                for (int m = 0; m < 4; ++m) { bf16* rowp = P + ((size_t)u.pn * T + (size_t)(row0 + ai * HALF + m * 16)) * 256 + col0;
#pragma unroll
                    for (int bj = 0; bj < 2; ++bj) { const f32x4 v0 = acc[ai][bj][m][0], v1 = acc[ai][bj][m][1];
                        u32x4 w; w.x = cvt_pk_bf16(v0[0], v0[1]); w.y = cvt_pk_bf16(v0[2], v0[3]); w.z = cvt_pk_bf16(v1[0], v1[1]); w.w = cvt_pk_bf16(v1[2], v1[3]);
                        *(u32x4*)(rowp + bj * HALF) = w; } }
        } else {
            const int col0 = (u.pn - 11) * BM + wc * 32 + 8 * fq;
#pragma unroll
            for (int ai = 0; ai < 2; ++ai)
#pragma unroll
                for (int m = 0; m < 4; ++m) { unsigned char* rowp = Gt + (size_t)(row0 + ai * HALF + m * 16) * NGATE + col0;
#pragma unroll
                    for (int bj = 0; bj < 2; ++bj) { const f32x4 v0 = acc[ai][bj][m][0], v1 = acc[ai][bj][m][1];
                        u32x2 w; w.x = q8x4(v0); w.y = q8x4(v1);
                        *(u32x2*)(rowp + bj * HALF) = w; } }
        }
        return false;
    }
};
template <class E, class = void> struct EpiFp8 { static constexpr bool v = false; };
template <class E> struct EpiFp8<E, decltype((void)E::FP8)> { static constexpr bool v = E::FP8; };
struct EpiGate8 {
    static constexpr bool PERM = true; static constexpr bool FP8 = true;
    unsigned char* Gt;
    __device__ __forceinline__ bool operator()(Acc& acc, const Unit& u, int wr, int wc, int fr, int fq) const {
        const int row0 = u.pm * BM + wr * 64 + fr, col0 = u.pn * BM + wc * 32 + 8 * fq;
#pragma unroll
        for (int ai = 0; ai < 2; ++ai)
#pragma unroll
            for (int m = 0; m < 4; ++m) { unsigned char* rowp = Gt + (size_t)(row0 + ai * HALF + m * 16) * NGATE + col0;
#pragma unroll
                for (int bj = 0; bj < 2; ++bj) { const f32x4 v0 = acc[ai][bj][m][0] * 0.03125f, v1 = acc[ai][bj][m][1] * 0.03125f;
                    u32x2 w; w.x = q8x4(v0); w.y = q8x4(v1);
                    *(u32x2*)(rowp + bj * HALF) = w; } }
        return false;
    }
};
struct EpiBranch {
    static constexpr bool PERM = true;
    const unsigned char* Gt; bf16* O;
    __device__ __forceinline__ bool operator()(Acc& acc, const Unit& u, int wr, int wc, int fr, int fq) const {
        const int row0 = u.pm * BM + wr * 64 + fr, col0 = u.pn * BM + wc * 32 + 8 * fq, sub = u.aux;
        const bool last = sub == 3;
        const int goff1 = last ? 0 : 1024;
        u32x2 G0[2][4][2], G1[2][4][2];
#pragma unroll
        for (int ai = 0; ai < 2; ++ai)
#pragma unroll
            for (int m = 0; m < 4; ++m) { const size_t row = (size_t)(row0 + ai * HALF + m * 16); const unsigned char* gp = Gt + row * NGATE + sub * 1024 + col0;
#pragma unroll
                for (int bj = 0; bj < 2; ++bj) { G0[ai][m][bj] = *(const u32x2*)(gp + bj * HALF); G1[ai][m][bj] = *(const u32x2*)(gp + goff1 + bj * HALF); } }
        __builtin_amdgcn_sched_barrier(0);
        const float sc = last ? 1.f / 255.f : 1.f;
#pragma unroll
        for (int ai = 0; ai < 2; ++ai)
#pragma unroll
            for (int m = 0; m < 4; ++m) { const size_t row = (size_t)(row0 + ai * HALF + m * 16);
#pragma unroll
                for (int bj = 0; bj < 2; ++bj) {
                    const u32x2 g0 = G0[ai][m][bj];
                    u32x2 g1 = G1[ai][m][bj]; if (last) g1 = (u32x2){0x01010101u, 0x01010101u};
                    f32x4 v0 = acc[ai][bj][m][0], v1 = acc[ai][bj][m][1];
#pragma unroll
                    for (int j = 0; j < 4; ++j) {
                        const float a0 = (float)((g0.x >> (8 * j)) & 255u), b0 = (float)((g1.x >> (8 * j)) & 255u);
                        const float a1 = (float)((g0.y >> (8 * j)) & 255u), b1 = (float)((g1.y >> (8 * j)) & 255u);
                        v0[j] *= a0 * sc * __builtin_amdgcn_rcpf(b0); v1[j] *= a1 * sc * __builtin_amdgcn_rcpf(b1);
                    }
                    acc[ai][bj][m][0] = v0; acc[ai][bj][m][1] = v1;
                    if (last) { u32x4 w; w.x = cvt_pk_bf16(v0[0], v0[1]); w.y = cvt_pk_bf16(v0[2], v0[3]); w.z = cvt_pk_bf16(v1[0], v1[1]); w.w = cvt_pk_bf16(v1[2], v1[3]);
                        *(u32x4*)(O + row * 1024 + col0 + bj * HALF) = w; }
                } }
        return sub < 3;
    }
};
struct EpiResid {
    static constexpr bool PERM = false;
    float* X;
    __device__ __forceinline__ bool operator()(Acc& acc, const Unit& u, int wr, int wc, int fr, int fq) const {
        const int row0 = u.pm * BM + wr * 64 + fr, col0 = u.pn * BM + wc * 32 + 4 * fq;
#pragma unroll
        for (int ai = 0; ai < 2; ++ai)
        {
            f32x4 xv[4][2][2];
#pragma unroll
            for (int m = 0; m < 4; ++m) { const float* rowp = X + (size_t)(row0 + ai * HALF + m * 16) * 1024 + col0;
#pragma unroll
                for (int bj = 0; bj < 2; ++bj)
#pragma unroll
                    for (int n = 0; n < 2; ++n) xv[m][bj][n] = *(const f32x4*)(rowp + bj * HALF + n * 16); }
            __builtin_amdgcn_sched_barrier(0);
#pragma unroll
            for (int m = 0; m < 4; ++m) { float* rowp = X + (size_t)(row0 + ai * HALF + m * 16) * 1024 + col0;
#pragma unroll
                for (int bj = 0; bj < 2; ++bj)
#pragma unroll
                    for (int n = 0; n < 2; ++n) *(f32x4*)(rowp + bj * HALF + n * 16) = xv[m][bj][n] + acc[ai][bj][m][n]; }
            __builtin_amdgcn_sched_barrier(0);
        }
        return false;
    }
};
struct EpiResidX {
    static constexpr bool PERM = false;
    float* X; bf16* XB; float* SSQ; const float* XI;
    __device__ __forceinline__ bool operator()(Acc& acc, const Unit& u, int wr, int wc, int fr, int fq) const {
        const int row0 = u.pm * BM + wr * 64 + fr, col0 = u.pn * BM + wc * 32 + 4 * fq;
#pragma unroll
        for (int ai = 0; ai < 2; ++ai)
        {
            f32x4 xv[4][2][2];
#pragma unroll
            for (int m = 0; m < 4; ++m) { const float* rowi = XI + (size_t)(row0 + ai * HALF + m * 16) * 1024 + col0;
#pragma unroll
                for (int bj = 0; bj < 2; ++bj)
#pragma unroll
                    for (int n = 0; n < 2; ++n) xv[m][bj][n] = *(const f32x4*)(rowi + bj * HALF + n * 16); }
            __builtin_amdgcn_sched_barrier(0);
#pragma unroll
            for (int m = 0; m < 4; ++m) { const size_t row = (size_t)(row0 + ai * HALF + m * 16); float* rowp = X + row * 1024 + col0; bf16* rowb = XB + row * 1024 + col0;
                float ss = 0.f;
#pragma unroll
                for (int bj = 0; bj < 2; ++bj)
#pragma unroll
                    for (int n = 0; n < 2; ++n) { f32x4* p = (f32x4*)(rowp + bj * HALF + n * 16); const f32x4 v = xv[m][bj][n] + acc[ai][bj][m][n]; *p = v;
                        u32x2 w; w.x = cvt_pk_bf16(v[0], v[1]); w.y = cvt_pk_bf16(v[2], v[3]); *(u32x2*)(rowb + bj * HALF + n * 16) = w;
                        ss += (v[0] * v[0] + v[1] * v[1]) + (v[2] * v[2] + v[3] * v[3]); }
                ss += __shfl_xor(ss, 16); ss += __shfl_xor(ss, 32);
                if (fq == 0) SSQ[row * 16 + u.pn * 4 + wc] = ss; }
            __builtin_amdgcn_sched_barrier(0);
        }
        return false;
    }
};
struct EpiGlu {
    static constexpr bool PERM = true;
    const bf16* YP; const float* bias; bf16* O;
    __device__ __forceinline__ bool operator()(Acc& acc, const Unit& u, int wr, int wc, int fr, int fq) const {
        const int row0 = u.pm * BM + wr * 64 + fr, col0 = wc * 32 + 8 * fq;
        f32x4 bv[2][2];
#pragma unroll
        for (int bj = 0; bj < 2; ++bj) { const int c = col0 + bj * HALF; bv[bj][0] = *(const f32x4*)(bias + c); bv[bj][1] = *(const f32x4*)(bias + c + 4); }
#pragma unroll
        for (int ai = 0; ai < 2; ++ai) {
            u32x4 ypv[4][2];
#pragma unroll
            for (int m = 0; m < 4; ++m) { const size_t row = (size_t)(row0 + ai * HALF + m * 16);
#pragma unroll
                for (int bj = 0; bj < 2; ++bj) ypv[m][bj] = *(const u32x4*)(YP + row * 256 + col0 + bj * HALF); }
            __builtin_amdgcn_sched_barrier(0);
#pragma unroll
            for (int m = 0; m < 4; ++m) { const size_t row = (size_t)(row0 + ai * HALF + m * 16);
#pragma unroll
                for (int bj = 0; bj < 2; ++bj) { const int c = col0 + bj * HALF;
                    const u32x4 yp = ypv[m][bj];
                    const f32x4 v0 = acc[ai][bj][m][0] + bv[bj][0], v1 = acc[ai][bj][m][1] + bv[bj][1];
                    u32x4 w;
                    w.x = cvt_pk_bf16(bflo(yp.x) * sigmoidf_(v0[0]), bfhi(yp.x) * sigmoidf_(v0[1])); w.y = cvt_pk_bf16(bflo(yp.y) * sigmoidf_(v0[2]), bfhi(yp.y) * sigmoidf_(v0[3]));
                    w.z = cvt_pk_bf16(bflo(yp.z) * sigmoidf_(v1[0]), bfhi(yp.z) * sigmoidf_(v1[1])); w.w = cvt_pk_bf16(bflo(yp.w) * sigmoidf_(v1[2]), bfhi(yp.w) * sigmoidf_(v1[3]));
                    *(u32x4*)(O + row * 1024 + 512 + c) = w;
                    asm volatile("" ::: "memory"); } }
            __builtin_amdgcn_sched_barrier(0);
        }
        return false;
    }
};
struct EpiGateUp {
    static constexpr bool PERM = true;
    bf16* O;
    __device__ __forceinline__ bool operator()(Acc& acc, const Unit& u, int wr, int wc, int fr, int fq) const {
        const int row0 = u.pm * BM + wr * 64 + fr, col0 = u.pn * HALF + wc * 32 + 8 * fq;
#pragma unroll
        for (int ai = 0; ai < 2; ++ai)
#pragma unroll
            for (int m = 0; m < 4; ++m) { const size_t row = (size_t)(row0 + ai * HALF + m * 16);
                const f32x4 g0 = acc[ai][0][m][0], g1 = acc[ai][0][m][1], u0 = acc[ai][1][m][0], u1 = acc[ai][1][m][1];
                float r[8];
#pragma unroll
                for (int j = 0; j < 4; ++j) { r[j] = g0[j] * sigmoidf_(g0[j]) * u0[j]; r[4 + j] = g1[j] * sigmoidf_(g1[j]) * u1[j]; }
                u32x4 w; w.x = cvt_pk_bf16(r[0], r[1]); w.y = cvt_pk_bf16(r[2], r[3]); w.z = cvt_pk_bf16(r[4], r[5]); w.w = cvt_pk_bf16(r[6], r[7]);
                *(u32x4*)(O + row * DFF + col0) = w; }
        return false;
    }
};

struct EpiGateUp8 {
    static constexpr bool PERM = true; static constexpr bool FP8 = true;
    unsigned char* O8;
    __device__ __forceinline__ bool operator()(Acc& acc, const Unit& u, int wr, int wc, int fr, int fq) const {
        const int row0 = u.pm * BM + wr * 64 + fr, col0 = u.pn * HALF + wc * 32 + 8 * fq;
#pragma unroll
        for (int ai = 0; ai < 2; ++ai)
#pragma unroll
            for (int m = 0; m < 4; ++m) { const size_t row = (size_t)(row0 + ai * HALF + m * 16);
                const f32x4 g0 = acc[ai][0][m][0] * 0.03125f, g1 = acc[ai][0][m][1] * 0.03125f, u0 = acc[ai][1][m][0] * 0.03125f, u1 = acc[ai][1][m][1] * 0.03125f;
                float r[8];
#pragma unroll
                for (int j = 0; j < 4; ++j) { r[j] = g0[j] * sigmoidf_(g0[j]) * u0[j]; r[4 + j] = g1[j] * sigmoidf_(g1[j]) * u1[j]; }
                int w0 = __builtin_amdgcn_cvt_pk_fp8_f32(16.f * r[0], 16.f * r[1], 0, false); w0 = __builtin_amdgcn_cvt_pk_fp8_f32(16.f * r[2], 16.f * r[3], w0, true);
                int w1 = __builtin_amdgcn_cvt_pk_fp8_f32(16.f * r[4], 16.f * r[5], 0, false); w1 = __builtin_amdgcn_cvt_pk_fp8_f32(16.f * r[6], 16.f * r[7], w1, true);
                *(u32x2*)(O8 + row * DFF + col0) = (u32x2){(unsigned)w0, (unsigned)w1}; }
        return false;
    }
};
struct EpiBf16S8 {
    static constexpr bool PERM = true; static constexpr bool FP8 = true;
    bf16* O; int ldc; float scale;
    __device__ __forceinline__ bool operator()(Acc& acc, const Unit& u, int wr, int wc, int fr, int fq) const {
        const int row0 = u.pm * BM + wr * 64 + fr, col0 = u.pn * BM + wc * 32 + 8 * fq;
#pragma unroll
        for (int ai = 0; ai < 2; ++ai)
#pragma unroll
            for (int m = 0; m < 4; ++m) { bf16* rowp = O + (size_t)(row0 + ai * HALF + m * 16) * ldc + col0;
#pragma unroll
                for (int bj = 0; bj < 2; ++bj) { const f32x4 v0 = acc[ai][bj][m][0] * scale, v1 = acc[ai][bj][m][1] * scale;
                    u32x4 w; w.x = cvt_pk_bf16(v0[0], v0[1]); w.y = cvt_pk_bf16(v0[2], v0[3]); w.z = cvt_pk_bf16(v1[0], v1[1]); w.w = cvt_pk_bf16(v1[2], v1[3]);
                    *(u32x4*)(rowp + bj * HALF) = w; } }
        return false;
    }
};

template <class Epi, class Sched>
__device__ __forceinline__ void gemm_phase(LAS unsigned char* lds, const int tid, const Sched& S, const Epi& E, const int K, const int lda, const int ldb) {
    const int wid = __builtin_amdgcn_readfirstlane(tid >> 6), lane = tid & 63, wr = wid >> 2, wc = wid & 3, fr = lane & 15, fq = lane >> 4;
    int nt = K / BK; asm volatile("" : "+s"(nt));
    constexpr bool GATHER = Sched::GATHER;
    unsigned voffA[2], voffB[2]; int gR[2], gC[2];
#pragma unroll
    for (int i = 0; i < 2; ++i) { int R, C; stage_rc(tid * 16 + i * 8192, R, C); const int Rb = Epi::PERM ? ((R & ~31) + perm32(R & 31)) : R; gR[i] = R; gC[i] = C;
        voffA[i] = (unsigned)(R * lda + C) * 2u; voffB[i] = (unsigned)(Rb * ldb + C) * 2u; }
    unsigned cvo[2][2], nvo[2][2];
#define PG8_GOFF(u_, out_) do { _Pragma("unroll") for (int _h = 0; _h < 2; ++_h) _Pragma("unroll") for (int _i = 0; _i < 2; ++_i) { const int _r = _h * HALF + gR[_i]; \
        const int _tok = (u_).amap[_r < (u_).avalid ? _r : (u_).avalid - 1]; out_[_h][_i] = (unsigned)_tok * (unsigned)(lda * 2) + (unsigned)gC[_i] * 2u; } } while (0)
#define PG8_STAGE_A(bufoff, base, h_, usenext) do { if constexpr (GATHER) { unsigned _vo[2]; _vo[0] = (usenext) ? nvo[h_][0] : cvo[h_][0]; _vo[1] = (usenext) ? nvo[h_][1] : cvo[h_][1]; PG8_STAGE(bufoff, base, _vo); } \
        else { PG8_STAGE(bufoff, (base) + (h_) * hstepA, voffA); } } while (0)
    const size_t kstep = (size_t)(BK * 2);
    const size_t hstepA = (size_t)HALF * lda * 2, hstepB = (size_t)HALF * ldb * 2;
    const unsigned ldsw = (unsigned)wid * 1024u;
    const int aoff = lds_byte(wr * 64 + fr, fq * 8), boff = lds_byte(wc * 32 + fr, fq * 8);
#define PG8_SA(b, h) (((b) * 2 + (h)) * HTB)
#define PG8_SB(b, h) ((4 + (b) * 2 + (h)) * HTB)
#define PG8_STAGE(bufoff, gbase, voff) do { _Pragma("unroll") for (int _i = 0; _i < 2; ++_i) \
        __builtin_amdgcn_global_load_lds((const unsigned*)((const char*)(gbase) + (voff)[_i]), (LAS unsigned*)(lds + (bufoff) + ldsw + _i * 8192), 16, 0, 0); } while (0)
#define PG8_LDA(dst, b, h) do { _Pragma("unroll") for (int m = 0; m < 4; ++m) { const i32x4_ lo_ = *(const LAS i32x4_*)(lds + PG8_SA(b, h) + aoff + m * 2048), hi_ = *(const LAS i32x4_*)(lds + PG8_SA(b, h) + aoff + m * 2048 + 1024); \
        dst[m] = __builtin_shufflevector(lo_, hi_, 0, 1, 2, 3, 4, 5, 6, 7); } } while (0)
#define PG8_LDB(dst, b, h) do { _Pragma("unroll") for (int n = 0; n < 2; ++n) { const i32x4_ lo_ = *(const LAS i32x4_*)(lds + PG8_SB(b, h) + boff + n * 2048), hi_ = *(const LAS i32x4_*)(lds + PG8_SB(b, h) + boff + n * 2048 + 1024); \
        dst[n] = __builtin_shufflevector(lo_, hi_, 0, 1, 2, 3, 4, 5, 6, 7); } } while (0)
#define PG8_K0(x) __builtin_bit_cast(bf16x8, __builtin_shufflevector(x, x, 0, 1, 2, 3))
#define PG8_K1(x) __builtin_bit_cast(bf16x8, __builtin_shufflevector(x, x, 4, 5, 6, 7))
#define PG8_MMA(ai, bj, At, Bt) do { __builtin_amdgcn_s_setprio(1); _Pragma("unroll") for (int m = 0; m < 4; ++m) _Pragma("unroll") for (int n = 0; n < 2; ++n) { \
        acc[ai][bj][m][n] = __builtin_amdgcn_mfma_f32_16x16x32_bf16(PG8_K0(Bt[n]), PG8_K0(At[m]), acc[ai][bj][m][n], 0, 0, 0); \
        acc[ai][bj][m][n] = __builtin_amdgcn_mfma_f32_16x16x32_bf16(PG8_K1(Bt[n]), PG8_K1(At[m]), acc[ai][bj][m][n], 0, 0, 0); } __builtin_amdgcn_s_setprio(0); } while (0)
#define PG8_MMA8(ai, bj, At, Bt) do { __builtin_amdgcn_s_setprio(1); _Pragma("unroll") for (int m = 0; m < 4; ++m) _Pragma("unroll") for (int n = 0; n < 2; ++n) \
        asm volatile("v_mfma_f32_16x16x128_f8f6f4 %0, %1, %2, %0" : "+v"(acc[ai][bj][m][n]) : "v"(Bt[n]), "v"(At[m])); __builtin_amdgcn_s_setprio(0); } while (0)
#define PG8_MM(ai, bj, At, Bt) do { if constexpr (EpiFp8<Epi>::v) { PG8_MMA8(ai, bj, At, Bt); } else { PG8_MMA(ai, bj, At, Bt); } } while (0)
#define PG8_WAIT_V(n) asm volatile("s_waitcnt vmcnt(" #n ")" ::: "memory")
#define PG8_WAIT_L(n) asm volatile("s_waitcnt lgkmcnt(" #n ")" ::: "memory")
#define PG8_BAR __builtin_amdgcn_s_barrier()
#define PG8_SCHED __builtin_amdgcn_sched_barrier(0)
    Unit cur, nxt; int ui = 0;
    if (!S.next(0, cur)) return;
    Acc acc;
#pragma unroll
    for (int a = 0; a < 2; ++a)
#pragma unroll
        for (int b = 0; b < 2; ++b)
#pragma unroll
            for (int m = 0; m < 4; ++m)
#pragma unroll
                for (int n = 0; n < 2; ++n) { float z_ = 0.f; if constexpr (EpiFp8<Epi>::v) asm volatile("" : "+v"(z_)); acc[a][b][m][n] = (f32x4){z_, z_, z_, z_}; }
    i32x8_ At[4], B0[2], B1[2];
    if constexpr (EpiFp8<Epi>::v) {
#pragma unroll
        for (int m = 0; m < 4; ++m) asm volatile("" : "=v"(At[m]));
#pragma unroll
        for (int n = 0; n < 2; ++n) { asm volatile("" : "=v"(B0[n])); asm volatile("" : "=v"(B1[n])); }
    }
    const char* cA = cur.A; const char* cB = cur.B;
    if constexpr (GATHER) { PG8_GOFF(cur, cvo); }
    PG8_STAGE(PG8_SB(0, 0), cB, voffB); PG8_STAGE(PG8_SB(0, 1), cB + hstepB, voffB); PG8_STAGE_A(PG8_SA(0, 0), cA, 0, false); PG8_STAGE_A(PG8_SA(0, 1), cA, 1, false);
    if (wr == 1) PG8_BAR;
    PG8_WAIT_V(2); PG8_BAR;
    PG8_STAGE(PG8_SB(1, 0), cB + kstep, voffB); PG8_STAGE_A(PG8_SA(1, 0), cA + kstep, 0, false); PG8_STAGE(PG8_SB(1, 1), cB + hstepB + kstep, voffB);
    PG8_WAIT_V(6); PG8_BAR;
    for (;;) {
        const bool has_next = S.next(ui + 1, nxt);
        const char* nA = has_next ? nxt.A : cA; const char* nB = has_next ? nxt.B : cB;
        if constexpr (GATHER) { if (has_next) { PG8_GOFF(nxt, nvo); } else {
#pragma unroll
                for (int _h = 0; _h < 2; ++_h) { nvo[_h][0] = cvo[_h][0]; nvo[_h][1] = cvo[_h][1]; } } }
        for (int t = 0; t < nt; t += 2) {
            const bool last = (t == nt - 2);
            const char* a1 = cA + (size_t)(t + 1) * kstep;
            const char* a2 = last ? nA : cA + (size_t)(t + 2) * kstep; const char* b2 = last ? nB : cB + (size_t)(t + 2) * kstep;
            const char* a3 = a2 + kstep; const char* b3 = b2 + kstep;
            PG8_LDB(B0, 0, 0); PG8_LDB(B1, 0, 1); PG8_SCHED; PG8_LDA(At, 0, 0); PG8_STAGE_A(PG8_SA(1, 1), a1, 1, false);
            PG8_WAIT_V(8); PG8_WAIT_L(0); PG8_BAR; PG8_MM(0, 0, At, B0); PG8_MM(0, 1, At, B1); PG8_BAR; PG8_SCHED;
            PG8_LDA(At, 0, 1); PG8_STAGE(PG8_SB(0, 0), b2, voffB); PG8_STAGE(PG8_SB(0, 1), b2 + hstepB, voffB); PG8_STAGE_A(PG8_SA(0, 0), a2, 0, last);
            PG8_WAIT_V(8); PG8_WAIT_L(0); PG8_BAR; PG8_MM(1, 0, At, B0); PG8_MM(1, 1, At, B1); PG8_BAR; PG8_SCHED;
            PG8_LDB(B0, 1, 0); PG8_LDB(B1, 1, 1); PG8_SCHED; PG8_LDA(At, 1, 0); PG8_STAGE_A(PG8_SA(0, 1), a2, 1, last);
            PG8_WAIT_V(8); PG8_WAIT_L(0); PG8_BAR; PG8_MM(0, 0, At, B0); PG8_MM(0, 1, At, B1); PG8_BAR; PG8_SCHED;
            PG8_LDA(At, 1, 1); PG8_STAGE(PG8_SB(1, 0), b3, voffB); PG8_STAGE(PG8_SB(1, 1), b3 + hstepB, voffB); PG8_STAGE_A(PG8_SA(1, 0), a3, 0, last);
            PG8_WAIT_V(8); PG8_WAIT_L(0); PG8_BAR; PG8_MM(1, 0, At, B0); PG8_MM(1, 1, At, B1); PG8_BAR; PG8_SCHED;
        }
        if (GEMM_ALIGN) { if (wr == 0) PG8_BAR; }
        if constexpr (EpiFp8<Epi>::v) {
#define PG8_ACC8(a, b) "+v"(acc[a][b][0][0]), "+v"(acc[a][b][0][1]), "+v"(acc[a][b][1][0]), "+v"(acc[a][b][1][1]), "+v"(acc[a][b][2][0]), "+v"(acc[a][b][2][1]), "+v"(acc[a][b][3][0]), "+v"(acc[a][b][3][1])
            asm volatile("s_nop 15\n\ts_nop 15\n\ts_nop 15\n\ts_nop 15\n\ts_nop 15" : PG8_ACC8(0, 0));
            asm volatile("" : PG8_ACC8(0, 1)); asm volatile("" : PG8_ACC8(1, 0)); asm volatile("" : PG8_ACC8(1, 1));
#undef PG8_ACC8
        }
        const bool keep = E(acc, cur, wr, wc, fr, fq);
        if (!has_next) break;
        if (!keep) {
#pragma unroll
            for (int a = 0; a < 2; ++a)
#pragma unroll
                for (int b = 0; b < 2; ++b)
#pragma unroll
                    for (int m = 0; m < 4; ++m)
#pragma unroll
                        for (int n = 0; n < 2; ++n) { float z_ = 0.f; if constexpr (EpiFp8<Epi>::v) asm volatile("" : "+v"(z_)); acc[a][b][m][n] = (f32x4){z_, z_, z_, z_}; }
        }
        cur = nxt; cA = nA; cB = nB; ++ui;
        if constexpr (GATHER) {
#pragma unroll
            for (int _h = 0; _h < 2; ++_h) { cvo[_h][0] = nvo[_h][0]; cvo[_h][1] = nvo[_h][1]; } }
        if (GEMM_ALIGN) { if (wr == 1) PG8_BAR; }
    }
    PG8_WAIT_V(0);
    if (!GEMM_ALIGN) { if (wr == 0) PG8_BAR; }
    PG8_BAR;
#undef PG8_SA
#undef PG8_SB
#undef PG8_STAGE
#undef PG8_STAGE_A
#undef PG8_GOFF
#undef PG8_LDA
#undef PG8_LDB
#undef PG8_MMA
#undef PG8_MMA8
#undef PG8_K0
#undef PG8_K1
#undef PG8_MM
#undef PG8_WAIT_V
#undef PG8_WAIT_L
#undef PG8_BAR
#undef PG8_SCHED
}
}

struct Args {
    const float* in[36]; float* out; unsigned char* ws; int ph_lo, ph_hi;
};
enum { I_X = 0, I_MEM, I_POS, I_NORM_MIX, I_W_IN, I_CONV_W, I_CONV_B, I_GLA_A_UP, I_GLA_A_B, I_GLA_NORM, I_S5_LRE, I_S5_LIM, I_S5_LOGDT, I_S5_BRE, I_S5_BIM, I_S5_CRE, I_S5_CIM, I_S5_D,
       I_S5_WGLU, I_S5_BGLU, I_W_BRANCH, I_W_OUT, I_NORM_CROSS, I_W_CQ, I_W_CKV, I_W_CO, I_NORM_FFN, I_W_RG, I_B_RG, I_W_RE, I_B_RE, I_W_EG, I_W_EU, I_W_ED, I_NORM_MEM, I_NORM_FINAL };

#define RELAUNDER_CTX(c0) Ctx c = (c0); { int _t = (c0).tid; asm volatile("" : "+v"(_t)); c.tid = _t; c.lane = _t & 63; c.wave = __builtin_amdgcn_readfirstlane(_t >> 6); }
struct Ctx { LAS unsigned char* lds; unsigned char* ws; int tid, lane, wave, G, vcu, gw, NGW, z, bx; };

template <class Src>
__device__ __forceinline__ void xpose_item(const Src& src, int ldw, bf16* WT, int ldt, int dst_k0, int kb, int nb, LAS float* scr, int lane, const float* kgain = nullptr, unsigned char* WT8 = nullptr) {
    const int k0 = 64 * kb, n0 = 32 * nb;
    const float* p = src(n0 + (lane & 31));
    float tv[32];
#pragma unroll
    for (int i = 0; i < 32; ++i) { const int kk = 2 * i + (lane >> 5); tv[i] = p ? p[(size_t)(k0 + kk) * ldw] : 0.f; }
#pragma unroll
    for (int i = 0; i < 32; ++i) { const int kk = 2 * i + (lane >> 5); scr[kk * 33 + (lane & 31)] = kgain ? tv[i] * kgain[k0 + kk] : tv[i]; }
    asm volatile("s_waitcnt lgkmcnt(0)" ::: "memory");
    const int c = lane & 7;
#pragma unroll
    for (int j = 0; j < 4; ++j) { const int n = (lane >> 3) + 8 * j; const LAS float* s = scr + (8 * c) * 33 + n;
        if (WT8) {
            int w0 = __builtin_amdgcn_cvt_pk_fp8_f32(32.f * s[0 * 33], 32.f * s[1 * 33], 0, false); w0 = __builtin_amdgcn_cvt_pk_fp8_f32(32.f * s[2 * 33], 32.f * s[3 * 33], w0, true);
            int w1 = __builtin_amdgcn_cvt_pk_fp8_f32(32.f * s[4 * 33], 32.f * s[5 * 33], 0, false); w1 = __builtin_amdgcn_cvt_pk_fp8_f32(32.f * s[6 * 33], 32.f * s[7 * 33], w1, true);
            *(u32x2*)(WT8 + (size_t)(n0 + n) * ldt + dst_k0 + k0 + 8 * c) = (u32x2){(unsigned)w0, (unsigned)w1};
        } else {
        u32x4 o; o.x = pk2(s[0 * 33], s[1 * 33]); o.y = pk2(s[2 * 33], s[3 * 33]); o.z = pk2(s[4 * 33], s[5 * 33]); o.w = pk2(s[6 * 33], s[7 * 33]);
        *(u32x4*)(WT + (size_t)(n0 + n) * ldt + dst_k0 + k0 + 8 * c) = o; } }
    asm volatile("s_waitcnt lgkmcnt(0)" ::: "memory");
}
struct SrcPlain { const float* W; __device__ __forceinline__ const float* operator()(int n) const { return W + n; } };
struct SrcWin { const float* W; __device__ __forceinline__ const float* operator()(int n) const {
        int c;
        if (n < 1792) c = n;
        else if (n < 2048) c = 1808 + (n - 1792);
        else if (n < 2304) c = 2064 + (n - 2048);
        else if (n < 2560) c = 2448 + (n - 2304);
        else if (n < 2624) c = 2320 + (n - 2560);
        else if (n < 2688) c = 2384 + (n - 2624);
        else if (n < 2720) c = 2704 + (n - 2688);
        else if (n < 2728) c = 2736 + (n - 2720);
        else if (n < 2736) c = -1;
        else if (n < 2752) c = 1792 + (n - 2736);
        else if (n < NPROJ) c = -1;
        else c = 2744 + (n - NPROJ);
        return c < 0 ? nullptr : W + c; } };
struct SrcGU { const float* Wg; const float* Wu; __device__ __forceinline__ const float* operator()(int n) const { const int pn = n >> 8, half = (n >> 7) & 1, j = n & 127; return Wg + (ptrdiff_t)half * (Wu - Wg) + 128 * pn + j; } };

__device__ __forceinline__ void conv_weights_nm(const Args& a, const Ctx& c, int l, int it) {
    LAS float* scr = (LAS float*)(c.lds + c.wave * 16384);
    unsigned char* wb = c.ws + WS_WNM + (size_t)l * WN_LAYER;
    int r = it;
    if (r < 16 * 216) { SrcWin s{a.in[I_W_IN + c.z] + (size_t)l * 1024 * D_IN}; const int nb = r % 216;
        xpose_item(s, D_IN, (bf16*)(wb + WN_IN), 1024, 0, r / 216, nb, scr, c.lane, nullptr, nb >= NPROJ / 32 ? wb + WN_IN + (size_t)NPROJ * 2048 - (size_t)NPROJ * 1024 : nullptr); return; } r -= 16 * 216;
    if (r < 512) { const int i = r >> 7, q = r & 127; SrcPlain s{a.in[I_W_BRANCH + c.z] + ((size_t)l * 4 + i) * 256 * 1024}; xpose_item(s, 1024, (bf16*)(wb + WN_BR), 1024, i * 256, q >> 5, q & 31, scr, c.lane); return; } r -= 512;
    if (r < 512) { SrcPlain s{a.in[I_W_OUT + c.z] + (size_t)l * 1024 * 1024}; xpose_item(s, 1024, (bf16*)(wb + WN_OUT), 1024, 0, r >> 5, r & 31, scr, c.lane); return; } r -= 512;
    if (r < 256) { SrcPlain s{a.in[I_W_CQ + c.z] + (size_t)l * 1024 * 512}; xpose_item(s, 512, (bf16*)(wb + WN_CQ), 1024, 0, r >> 4, r & 15, scr, c.lane, a.in[I_NORM_CROSS + c.z] + (size_t)l * 1024); return; } r -= 256;
    if (r < 512) { SrcPlain s{a.in[I_W_CKV + c.z] + (size_t)l * 1024 * 1024}; xpose_item(s, 1024, (bf16*)(wb + WN_CKV), 1024, 0, r >> 5, r & 31, scr, c.lane); return; } r -= 512;
    if (r < 256) { SrcPlain s{a.in[I_W_CO + c.z] + (size_t)l * 512 * 1024}; xpose_item(s, 1024, (bf16*)(wb + WN_CO), 512, 0, r >> 5, r & 31, scr, c.lane); return; } r -= 256;
    { SrcPlain s{a.in[I_S5_WGLU + c.z] + (size_t)l * 256 * 256}; xpose_item(s, 256, (bf16*)(wb + WN_GLU), 256, 0, r >> 3, r & 7, scr, c.lane); }
}
constexpr int NM_ITEMS = 16 * 216 + 512 + 512 + 256 + 512 + 256 + 32;
__device__ __forceinline__ void conv_weights_moe(const Args& a, const Ctx& c, int l, int it) {
    LAS float* scr = (LAS float*)(c.lds + c.wave * 16384);
    unsigned char* wb = c.ws + WS_WMOE;
    int r = it;
    if (r < 16 * 512) { const int e = r >> 9, q = r & 511; SrcGU s{a.in[I_W_EG + c.z] + ((size_t)l * 16 + e) * 1024 * 512, a.in[I_W_EU + c.z] + ((size_t)l * 16 + e) * 1024 * 512};
        xpose_item(s, 512, (bf16*)(wb + WM_GU), 1024, 0, q >> 5, q & 31, scr, c.lane, nullptr, wb + WM_GU + (size_t)e * 1024 * 1024); return; } r -= 16 * 512;
    { const int e = r >> 8, q = r & 255; SrcPlain s{a.in[I_W_ED + c.z] + ((size_t)l * 16 + e) * 512 * 1024}; xpose_item(s, 1024, (bf16*)(wb + WM_DN), 512, 0, q >> 5, q & 31, scr, c.lane, nullptr, wb + WM_DN + (size_t)e * 1024 * 512); }
}
constexpr int MOE_ITEMS = 16 * 512 + 16 * 256;

__device__ __forceinline__ void s5_tables_job(const Args& a, const Ctx& c, int job) {
    const int l = job >> 7, g = (job >> 3) & 15, part = job & 7;
    LAS f32x2* PW = (LAS f32x2*)(c.lds);
    LAS f32x2* BB = PW + 64 * 17;
    LAS f32x2* CC = BB + 64 * 16;
    __syncthreads();
    if (c.tid < 64) {
        const int p = c.tid;
        const double dt = exp((double)a.in[I_S5_LOGDT + c.z][l * 16 + g]);
        const double lr = (double)a.in[I_S5_LRE + c.z][(l * 16 + g) * 64 + p], li = (double)a.in[I_S5_LIM + c.z][(l * 16 + g) * 64 + p];
        const double mag = exp(lr * dt), br = mag * cos(li * dt), bi = mag * sin(li * dt);
        double xr = 1.0, xi = 0.0;
        for (int k = 0; k <= 16; ++k) { PW[p * 17 + k] = (f32x2){(float)xr, (float)xi}; const double nr = xr * br - xi * bi, ni = xr * bi + xi * br; xr = nr; xi = ni; }
        const double den = lr * lr + li * li;
        const double fr = ((br - 1.0) * lr + bi * li) / den, fi = (bi * lr - (br - 1.0) * li) / den;
        for (int ch = 0; ch < 16; ++ch) {
            const double b_re = (double)a.in[I_S5_BRE + c.z][((size_t)(l * 16 + g) * 64 + p) * 16 + ch], b_im = (double)a.in[I_S5_BIM + c.z][((size_t)(l * 16 + g) * 64 + p) * 16 + ch];
            BB[p * 16 + ch] = (f32x2){(float)(fr * b_re - fi * b_im), (float)(fr * b_im + fi * b_re)};
        }
        if (part == 0) ((f32x2*)(c.ws + WS_LAML))[(l * 16 + g) * 64 + p] = PW[p * 17 + 16];
    }
    for (int i = c.tid; i < 1024; i += NTHR) { const int ch = i >> 6, p = i & 63;
        CC[ch * 64 + p] = (f32x2){a.in[I_S5_CRE + c.z][((size_t)(l * 16 + g) * 16 + ch) * 64 + p], a.in[I_S5_CIM + c.z][((size_t)(l * 16 + g) * 16 + ch) * 64 + p]}; }
    __syncthreads();
    unsigned char* wb = c.ws + WS_WNM + (size_t)l * WN_LAYER;
    bf16* We = (bf16*)(wb + WN_S5E) + (size_t)g * 128 * 256;
    bf16* Bc = (bf16*)(wb + WN_S5B) + (size_t)g * 256 * 384;
    for (int i = c.tid; i < 16 * 256; i += NTHR) { const int q = 16 * part + (i >> 8), k = i & 255, s = k >> 4, ch = k & 15, p = q & 63;
        const f32x2 w = PW[p * 17 + 15 - s], b = BB[p * 16 + ch];
        const float v = (q < 64) ? (w.x * b.x - w.y * b.y) : (w.x * b.y + w.y * b.x);
        We[(size_t)q * 256 + k] = (bf16)f2bf(v); }
    for (int i = c.tid; i < 32 * 384; i += NTHR) { const int row = 32 * part + i / 384, k = i % 384, t = row >> 4, ch = row & 15;
        float v = 0.f;
        if (k < 256) { const int s = k >> 4, c2 = k & 15;
            if (s <= t) { for (int p = 0; p < 64; ++p) { const f32x2 cc = CC[ch * 64 + p], w = PW[p * 17 + (t - s)], b = BB[p * 16 + c2];
                    const float gr = cc.x * w.x - cc.y * w.y, gi = cc.x * w.y + cc.y * w.x; v += gr * b.x - gi * b.y; } } }
        else { const int p = (k - 256) & 63; const f32x2 cc = CC[ch * 64 + p], w = PW[p * 17 + t + 1];
            const float gr = cc.x * w.x - cc.y * w.y, gi = cc.x * w.y + cc.y * w.x; v = (k < 320) ? gr : -gi; }
        Bc[(size_t)row * 384 + k] = (bf16)f2bf(v); }
}

__device__ __forceinline__ void load_row(const float* xrow, int lane, f32x4 (&v)[4]) {
    const f32x4* xr = (const f32x4*)xrow + lane;
#pragma unroll
    for (int j = 0; j < 4; ++j) v[j] = xr[64 * j];
}
__device__ __forceinline__ float row_rstd(const f32x4 (&v)[4]) {
    float s = 0.f;
#pragma unroll
    for (int j = 0; j < 4; ++j) s += (v[j].x * v[j].x + v[j].y * v[j].y) + (v[j].z * v[j].z + v[j].w * v[j].w);
    return 1.f / sqrtf(wave_sum(s) * (1.f / 1024.f) + EPS);
}
__device__ __forceinline__ void store_row_bf16(bf16* orow, int lane, const f32x4 (&v)[4]) {
    u32x2* o8 = (u32x2*)orow + lane;
#pragma unroll
    for (int j = 0; j < 4; ++j) { u32x2 w; w.x = pk2(v[j].x, v[j].y); w.y = pk2(v[j].z, v[j].w); o8[64 * j] = w; }
}
template <int MODE, bool FINAL>
__device__ __forceinline__ void norm_phase(const Args& a, const Ctx& c, const float* gain, int lmoe = 0) {
    bf16* HY = (bf16*)(c.ws + WS_HY);
    f32x4 g[4]; load_row(gain, c.lane, g);
    const int* tokpos = (const int*)(c.ws + WS_TOKPOS); const float* tokw = (const float*)(c.ws + WS_TOKW); const bf16* OB = (const bf16*)(c.ws + WS_OB);
    constexpr int NR = (MODE == 2) ? 2 : 4;
    int seg[16];
    if (MODE == 2) { const unsigned* gcnt = (const unsigned*)(c.ws + WS_CTL) + CW_MOECNT + lmoe * 64; int acc = 0;
#pragma unroll
        for (int e = 0; e < 16; ++e) { seg[e] = acc * 256; acc += (int)((gcnt[e] + 255u) >> 8); } }
    for (int row0 = c.gw * NR; row0 < T; row0 += c.NGW * NR) {
        f32x4 v[NR][4];
        u32x2 q0[NR][4], q1[NR][4]; float w0[NR], w1[NR];
#pragma unroll
        for (int r = 0; r < NR; ++r) { const int row = row0 + r;
            if (MODE == 0) load_row(a.in[I_X + c.z] + (size_t)row * 1024, c.lane, v[r]); else load_row(a.out + (size_t)row * 1024, c.lane, v[r]);
            if (MODE == 2) { const int k0 = tokpos[2 * row], k1 = tokpos[2 * row + 1]; w0[r] = tokw[2 * row]; w1[r] = tokw[2 * row + 1];
                int p0 = k0 & 0xffffff, p1 = k1 & 0xffffff;
#pragma unroll
                for (int e = 0; e < 16; ++e) { if (((k0 >> 24) & 255) == e) p0 += seg[e]; if (((k1 >> 24) & 255) == e) p1 += seg[e]; }
                const u32x2* r0 = (const u32x2*)(OB + (size_t)p0 * 1024) + c.lane; const u32x2* r1 = (const u32x2*)(OB + (size_t)p1 * 1024) + c.lane;
#pragma unroll
                for (int j = 0; j < 4; ++j) { q0[r][j] = r0[64 * j]; q1[r][j] = r1[64 * j]; } } }
#pragma unroll
        for (int r = 0; r < NR; ++r) { const int row = row0 + r;
            if (MODE == 2) {
#pragma unroll
                for (int j = 0; j < 4; ++j) { const u32x2 a0 = q0[r][j], a1 = q1[r][j];
                    v[r][j].x += w0[r] * bflo(a0.x) + w1[r] * bflo(a1.x); v[r][j].y += w0[r] * bfhi(a0.x) + w1[r] * bfhi(a1.x);
                    v[r][j].z += w0[r] * bflo(a0.y) + w1[r] * bflo(a1.y); v[r][j].w += w0[r] * bfhi(a0.y) + w1[r] * bfhi(a1.y); }
                if (!FINAL) { f32x4* o = (f32x4*)(a.out + (size_t)row * 1024) + c.lane;
#pragma unroll
                    for (int j = 0; j < 4; ++j) o[64 * j] = v[r][j]; }
            }
            const float rstd = row_rstd(v[r]);
#pragma unroll
            for (int j = 0; j < 4; ++j) v[r][j] = v[r][j] * rstd * g[j];
            if (FINAL) { f32x4* o = (f32x4*)(a.out + (size_t)row * 1024) + c.lane;
#pragma unroll
                for (int j = 0; j < 4; ++j) o[64 * j] = v[r][j]; }
            else { store_row_bf16(HY + (size_t)row * 1024, c.lane, v[r]);
                if (MODE != 1) { int* o8 = (int*)(c.ws + WS_H8 + (size_t)row * 1024) + c.lane;
#pragma unroll
                    for (int j = 0; j < 4; ++j) { int w = __builtin_amdgcn_cvt_pk_fp8_f32(v[r][j].x, v[r][j].y, 0, false); w = __builtin_amdgcn_cvt_pk_fp8_f32(v[r][j].z, v[r][j].w, w, true); o8[64 * j] = w; } } }
        }
    }
}
__device__ __forceinline__ void memn_phase(const Args& a, const Ctx& c) {
    bf16* MN = (bf16*)(c.ws + WS_MEMN);
    f32x4 g[4]; load_row(a.in[I_NORM_MEM + c.z], c.lane, g);
    for (int row = c.gw; row < MROWS; row += c.NGW) {
        f32x4 v[4]; load_row(a.in[I_MEM + c.z] + (size_t)row * 1024, c.lane, v);
        const float rstd = row_rstd(v);
#pragma unroll
        for (int j = 0; j < 4; ++j) v[j] = v[j] * rstd * g[j];
        store_row_bf16(MN + (size_t)row * 1024, c.lane, v);
    }
}

__device__ __forceinline__ void ffn_norm_route_phase(const Args& a, const Ctx& c, int l) {
    bf16* HY = (bf16*)(c.ws + WS_HY);
    int* tokpos = (int*)(c.ws + WS_TOKPOS); float* tokw = (float*)(c.ws + WS_TOKW); int* rowmap = (int*)(c.ws + WS_ROWMAP);
    unsigned* gcnt = (unsigned*)(c.ws + WS_CTL) + CW_MOECNT + l * 64;
    LAS int* lcnt = (LAS int*)(c.lds + 140000);
    LAS int* lrow = (LAS int*)(c.lds + 140000 + 256);
    const float* gain = a.in[I_NORM_FFN + c.z] + (size_t)l * 1024;
    const float* wrg = a.in[I_W_RG + c.z] + (size_t)l * 1024 * 4; const float* wre = a.in[I_W_RE + c.z] + (size_t)l * 1024 * 16;
    const float* brg = a.in[I_B_RG + c.z] + l * 4; const float* bre = a.in[I_B_RE + c.z] + l * 16;
    f32x4 g[4]; load_row(gain, c.lane, g);
    const int rows_per = (T + c.G - 1) / c.G;
    for (int base = c.bx * rows_per; base < T; base += c.G * rows_per) {
        __syncthreads();
        if (c.tid < 32) lcnt[c.tid] = 0;
        __syncthreads();
        LAS float* WRE = (LAS float*)c.lds;
        for (int i = c.tid; i < 4 * 16 * 64; i += NTHR) { const int gq = i >> 10, je = (i >> 6) & 15, ln = i & 63; const int k = 4 * ln + 256 * (je >> 2) + (je & 3);
            *(LAS f32x4*)(WRE + (size_t)i * 4) = *(const f32x4*)(wre + (size_t)k * 16 + 4 * gq); }
        __syncthreads();
        f32x4 wgv[4][4];
#pragma unroll
        for (int j = 0; j < 4; ++j)
#pragma unroll
            for (int e = 0; e < 4; ++e) wgv[j][e] = *(const f32x4*)(wrg + (size_t)(4 * c.lane + 256 * j + e) * 4);
        f32x4 vpre[4]; if (c.wave < rows_per && base + c.wave < T) load_row(a.out + (size_t)(base + c.wave) * 1024, c.lane, vpre);
#pragma unroll 1
        for (int lr = c.wave; lr < rows_per && base + lr < T; lr += NWAVES) {
            const int row = base + lr;
            f32x4 v[4];
#pragma unroll
            for (int j = 0; j < 4; ++j) v[j] = vpre[j];
            { const int ln = lr + NWAVES; const int rn = (ln < rows_per && base + ln < T) ? base + ln : row; load_row(a.out + (size_t)rn * 1024, c.lane, vpre); }
            const float rstd = row_rstd(v);
#pragma unroll
            for (int j = 0; j < 4; ++j) v[j] = v[j] * rstd * g[j];
            { int* o8 = (int*)(c.ws + WS_H8F + (size_t)row * 1024) + c.lane;
#pragma unroll
              for (int jq = 0; jq < 4; ++jq) { int w = __builtin_amdgcn_cvt_pk_fp8_f32(v[jq].x, v[jq].y, 0, false); w = __builtin_amdgcn_cvt_pk_fp8_f32(v[jq].z, v[jq].w, w, true); o8[64 * jq] = w; } }
            float gl[4] = {0.f, 0.f, 0.f, 0.f};
#pragma unroll
            for (int j = 0; j < 4; ++j) {
#pragma unroll
                for (int e = 0; e < 4; ++e) { const f32x4 w = wgv[j][e];
                    const float hv = v[j][e]; gl[0] += hv * w.x; gl[1] += hv * w.y; gl[2] += hv * w.z; gl[3] += hv * w.w; } }
#pragma unroll
            for (int q = 0; q < 4; ++q) gl[q] = wave_sum(gl[q]) + brg[q];
            int gs = 0; float gm = gl[0];
#pragma unroll
            for (int q = 1; q < 4; ++q) if (gl[q] > gm) { gm = gl[q]; gs = q; }
            float gsum = 0.f;
#pragma unroll
            for (int q = 0; q < 4; ++q) gsum += __expf(gl[q] - gm);
            const float pg = 1.f / gsum;
            float el[4] = {0.f, 0.f, 0.f, 0.f};
#pragma unroll
            for (int j = 0; j < 4; ++j) {
#pragma unroll
                for (int e = 0; e < 4; ++e) { const f32x4 w = *(const LAS f32x4*)(WRE + ((size_t)(gs * 16 + j * 4 + e) * 64 + c.lane) * 4);
                    const float hv = v[j][e]; el[0] += hv * w.x; el[1] += hv * w.y; el[2] += hv * w.z; el[3] += hv * w.w; } }
#pragma unroll
            for (int q = 0; q < 4; ++q) el[q] = wave_sum(el[q]) + bre[4 * gs + q];
            int i0 = 0; float m0 = el[0];
#pragma unroll
            for (int q = 1; q < 4; ++q) if (el[q] > m0) { m0 = el[q]; i0 = q; }
            int i1 = -1; float m1 = -3.0e38f;
#pragma unroll
            for (int q = 0; q < 4; ++q) if (q != i0 && el[q] > m1) { m1 = el[q]; i1 = q; }
            const float e1 = __expf(m1 - m0); const float t0 = 1.f / (1.f + e1), t1 = e1 * t0;
            if (c.lane == 0) {
                const int e0x = gs * 4 + i0, e1x = gs * 4 + i1;
                const int r0 = atomicAdd((int*)&lcnt[e0x], 1), r1 = atomicAdd((int*)&lcnt[e1x], 1);
                lrow[lr * 4 + 0] = e0x; lrow[lr * 4 + 1] = e1x; lrow[lr * 4 + 2] = r0; lrow[lr * 4 + 3] = r1;
                tokw[2 * row] = pg * t0; tokw[2 * row + 1] = pg * t1;
            }
        }
        __syncthreads();
        if (c.tid < 16) { const int n = lcnt[c.tid]; lcnt[16 + c.tid] = n ? (int)atomicAdd(gcnt + c.tid, (unsigned)n) : 0; }
        __syncthreads();
        for (int lr = c.tid; lr < rows_per && base + lr < T; lr += NTHR) {
            const int row = base + lr; const int e0x = lrow[lr * 4], e1x = lrow[lr * 4 + 1];
            const int i0x = lcnt[16 + e0x] + lrow[lr * 4 + 2], i1x = lcnt[16 + e1x] + lrow[lr * 4 + 3];
            tokpos[2 * row] = (e0x << 24) | i0x; tokpos[2 * row + 1] = (e1x << 24) | i1x;
            rowmap[(size_t)e0x * CAPE + i0x] = row; rowmap[(size_t)e1x * CAPE + i1x] = row;
        }
    }
}
__device__ __forceinline__ void moe_tables(const Ctx& c, int l, LAS int* tb) {
    const unsigned* gcnt = (const unsigned*)(c.ws + WS_CTL) + CW_MOECNT + l * 64;
    __syncthreads();
    if (c.tid < 16) tb[17 + c.tid] = (int)gcnt[c.tid];
    __syncthreads();
    if (c.tid == 0) { int acc = 0; tb[0] = 0; for (int e = 0; e < 16; ++e) { acc += (tb[17 + e] + 255) >> 8; tb[e + 1] = acc; } }
    __syncthreads();
}
#ifndef DPP_U
#define DPP_U(v, old, ctrl) ((unsigned)__builtin_amdgcn_update_dpp((int)(old), (int)(v), (ctrl), 0xF, 0xF, false))
#endif

struct TokRaw { u32x2 h0, c0, h1, c1, h2, c2, bg; int pos; unsigned qa, qb_, qs[3], w, ia, ib, is[3], ka, kb_, kx, vx; };
__device__ __forceinline__ void token_load(const Ctx& c, const int* pos, int t, TokRaw& R) {
    const bf16* P = (const bf16*)(c.ws + WS_PROJ);
#define PR(tt, col) (P + POFF((tt), (col)))
    const int s = t & (SEQ - 1), t1 = s >= 1 ? t - 1 : t, t2 = s >= 2 ? t - 2 : t, j8 = c.lane & 7;
    R.h0 = *(const u32x2*)(PR(t, C_CH) + 4 * c.lane); R.c0 = *(const u32x2*)(PR(t, C_CC) + 4 * c.lane);
    R.h1 = *(const u32x2*)(PR(t1, C_CH) + 4 * c.lane); R.c1 = *(const u32x2*)(PR(t1, C_CC) + 4 * c.lane);
    R.h2 = *(const u32x2*)(PR(t2, C_CH) + 4 * c.lane); R.c2 = *(const u32x2*)(PR(t2, C_CC) + 4 * c.lane);
    R.bg = *(const u32x2*)(PR(t, C_CB) + 4 * c.lane);
    R.pos = pos[t];
    { const bf16* q = (c.lane < 32) ? PR(t, C_DQ) + (c.lane >> 3) * 64 + j8 : PR(t, C_DK) + j8; R.qa = q[0]; R.qb_ = q[8]; }
#pragma unroll
    for (int i = 0; i < 3; ++i) { const int e = c.lane + 64 * i, hd = e / 48, dd = 16 + e % 48; R.qs[i] = PR(t, C_DQ)[hd * 64 + dd]; }
    const int hh = c.lane >> 3;
    R.w = PR(t, C_IW)[hh];
    { const bf16* q = PR(t, C_IQ) + hh * 32; const int j = c.lane & 3; R.ia = q[j]; R.ib = q[j + 4];
#pragma unroll
      for (int i = 0; i < 3; ++i) R.is[i] = q[8 + j8 * 3 + i]; }
    { const bf16* k = PR(t, C_IK); const int j = c.lane & 3; R.ka = k[j]; R.kb_ = k[j + 4]; }
    R.vx = PR(t, C_DV)[c.lane];
    R.kx = PR(t, C_DK)[c.lane];
#undef PR
}
__device__ __forceinline__ void token_prep_phase(const Args& a, const Ctx& c, int l) {
    bf16* P = (bf16*)(c.ws + WS_PROJ); bf16* HY = (bf16*)(c.ws + WS_HY);
    const int* pos = (const int*)a.in[I_POS + c.z];
    const float* cw = a.in[I_CONV_W + c.z] + (size_t)l * 3 * 256; const float* cb = a.in[I_CONV_B + c.z] + (size_t)l * 256;
    const f32x4 w0 = *(const f32x4*)(cw + 4 * c.lane), w1 = *(const f32x4*)(cw + 256 + 4 * c.lane), w2 = *(const f32x4*)(cw + 512 + 4 * c.lane), wb = *(const f32x4*)(cb + 4 * c.lane);
    const int j8 = c.lane & 7;
    const float invf = powf(500000.f, -(float)j8 * 0.125f);
    int t = c.gw; if (t >= T) return;
    TokRaw cur; token_load(c, pos, t, cur);
#pragma unroll 1
    for (; t < T; t += c.NGW) {
#define PR(tt, col) (P + POFF((tt), (col)))
        TokRaw nxt; { const int tn = t + c.NGW; token_load(c, pos, tn < T ? tn : t, nxt); }
        const TokRaw& R = cur;
        const int s = t & (SEQ - 1);
        {
            const f32x4 u0 = {bflo(R.h0.x) * bflo(R.c0.x), bfhi(R.h0.x) * bfhi(R.c0.x), bflo(R.h0.y) * bflo(R.c0.y), bfhi(R.h0.y) * bfhi(R.c0.y)};
            f32x4 u1 = {bflo(R.h1.x) * bflo(R.c1.x), bfhi(R.h1.x) * bfhi(R.c1.x), bflo(R.h1.y) * bflo(R.c1.y), bfhi(R.h1.y) * bfhi(R.c1.y)};
            f32x4 u2 = {bflo(R.h2.x) * bflo(R.c2.x), bfhi(R.h2.x) * bfhi(R.c2.x), bflo(R.h2.y) * bflo(R.c2.y), bfhi(R.h2.y) * bfhi(R.c2.y)};
            if (s < 1) u1 = (f32x4){0.f, 0.f, 0.f, 0.f};
            if (s < 2) u2 = (f32x4){0.f, 0.f, 0.f, 0.f};
            const f32x4 y = w0 * u2 + w1 * u1 + w2 * u0 + wb;
            u32x2 o; o.x = pk2(bflo(R.bg.x) * y.x, bfhi(R.bg.x) * y.y); o.y = pk2(bflo(R.bg.y) * y.z, bfhi(R.bg.y) * y.w);
            *(u32x2*)(HY + (size_t)t * 1024 + 4 * c.lane) = o;
        }
        const float ang = (float)R.pos * invf;
        float sn, cs; sincosf(ang, &sn, &cs);
        { const float x1 = bf2f(R.qa), x2 = bf2f(R.qb_);
          if (c.lane < 32) { bf16* q = PR(t, C_DQ) + (c.lane >> 3) * 64 + j8; q[0] = (bf16)f2bf((x1 * cs - x2 * sn) * 0.125f); q[8] = (bf16)f2bf((x2 * cs + x1 * sn) * 0.125f); }
          else if (c.lane < 40) { bf16* k = PR(t, C_DK) + j8; k[0] = (bf16)f2bf(x1 * cs - x2 * sn); k[8] = (bf16)f2bf(x2 * cs + x1 * sn); }
          const float r0 = bf2f(f2bf(x1 * cs - x2 * sn)), r8 = bf2f(f2bf(x2 * cs + x1 * sn));
          const float v0 = __shfl(r0, 32 + j8), v8 = __shfl(r8, 32 + j8);
          const float kval = c.lane < 8 ? v0 : (c.lane < 16 ? v8 : bf2f(R.kx));
          const float k1 = __uint_as_float(DPP_U(__float_as_uint(kval), __float_as_uint(kval), 0x55)), k2 = __uint_as_float(DPP_U(__float_as_uint(kval), __float_as_uint(kval), 0xAA)),
                      k3 = __uint_as_float(DPP_U(__float_as_uint(kval), __float_as_uint(kval), 0xFF));
          int w8 = __builtin_amdgcn_cvt_pk_fp8_f32(kval, k1, 0, false); w8 = __builtin_amdgcn_cvt_pk_fp8_f32(k2, k3, w8, true);
          if ((c.lane & 3) == 0) *(int*)(c.ws + WS_K8 + (size_t)t * 64 + c.lane) = w8;
          const float vval = bf2f(R.vx);
          const float u1 = __uint_as_float(DPP_U(__float_as_uint(vval), __float_as_uint(vval), 0x55)), u2 = __uint_as_float(DPP_U(__float_as_uint(vval), __float_as_uint(vval), 0xAA)),
                      u3 = __uint_as_float(DPP_U(__float_as_uint(vval), __float_as_uint(vval), 0xFF));
          int x8 = __builtin_amdgcn_cvt_pk_fp8_f32(vval, u1, 0, false); x8 = __builtin_amdgcn_cvt_pk_fp8_f32(u2, u3, x8, true);
          if ((c.lane & 3) == 0) *(int*)(c.ws + WS_V8 + (size_t)t * 64 + c.lane) = x8; }
#pragma unroll
        for (int i = 0; i < 3; ++i) { const int e = c.lane + 64 * i, hd = e / 48, dd = 16 + e % 48; PR(t, C_DQ)[hd * 64 + dd] = (bf16)f2bf(bf2f(R.qs[i]) * 0.125f); }
        const float cs4 = __shfl(cs, 2 * (c.lane & 3)), sn4 = __shfl(sn, 2 * (c.lane & 3));
        const float wsc = 0.0625f;
        const int hh = c.lane >> 3;
        const float wh = bf2f(R.w); const float aw = fabsf(wh) * wsc;
        {   bf16* q = PR(t, C_IQ) + hh * 32;
            const float sgn = wh < 0.f ? -1.f : 1.f;
            float sl[5];
            { const int j = c.lane & 3; const float x1 = bf2f(R.ia), x2 = bf2f(R.ib);
              const bf16 o1 = (bf16)f2bf((x1 * cs4 - x2 * sn4) * aw), o2 = (bf16)f2bf((x2 * cs4 + x1 * sn4) * aw);
              if ((c.lane & 7) < 4) { q[j] = o1; q[j + 4] = o2; }
              sl[0] = sgn * bf2f(o1); sl[1] = sgn * bf2f(o2); }
#pragma unroll
            for (int i = 0; i < 3; ++i) { const int dd = 8 + (c.lane & 7) * 3 + i; const bf16 o = (bf16)f2bf(bf2f(R.is[i]) * aw); q[dd] = o; sl[2 + i] = sgn * bf2f(o); }
#pragma unroll
            for (int i = 0; i < 5; ++i) { sl[i] += __shfl_xor(sl[i], 8); sl[i] += __shfl_xor(sl[i], 16); sl[i] += __shfl_xor(sl[i], 32); }
            if (c.lane < 8) { bf16* ql = PR(t, C_IL);
                if (c.lane < 4) { ql[c.lane] = (bf16)f2bf(sl[0]); ql[c.lane + 4] = (bf16)f2bf(sl[1]); }
#pragma unroll
                for (int i = 0; i < 3; ++i) ql[8 + c.lane * 3 + i] = (bf16)f2bf(sl[2 + i]); }
        }
        if (c.lane < 4) { bf16* k = PR(t, C_IK); const int j = c.lane; const float x1 = bf2f(R.ka), x2 = bf2f(R.kb_);
            k[j] = (bf16)f2bf(x1 * cs4 - x2 * sn4); k[j + 4] = (bf16)f2bf(x2 * cs4 + x1 * sn4); }
        if ((c.lane & 7) == 0) PR(t, C_IW)[hh] = (bf16)(wh < 0.f ? 0xBF80u : 0x3F80u);
        cur = nxt;
#undef PR
    }
}

constexpr int GL_QD = 0, GL_KI = 9216, GL_KET = 18432, GL_VT = 27648, GL_ATT = 36864, GL_ST = 46080, GL_AL = 55296  , GL_PART = 59392  , GL_OF = 61440  ;
struct GlaCommon { float bc[8]; float blast; };
struct GlaW { float au[16]; float ab; float gn; };
template <int PH> struct GlaRaw { unsigned al; unsigned k[8], v[8], q[PH == 3 ? 8 : 1], r[PH == 3 ? 8 : 1]; float st[PH == 3 ? 8 : 1]; };
__device__ __forceinline__ void gla_load_w(const Args& a, const Ctx& c, int l, int h, GlaW& W) {
#pragma unroll
    for (int r = 0; r < 16; ++r) W.au[r] = a.in[I_GLA_A_UP + c.z][((size_t)l * 16 + r) * 256 + h * 64 + c.lane];
    W.ab = a.in[I_GLA_A_B + c.z][l * 256 + h * 64 + c.lane]; W.gn = a.in[I_GLA_NORM + c.z][l * 256 + h * 64 + c.lane];
}
template <int PH>
__device__ __forceinline__ void gla_load(const Ctx& c, int task, GlaRaw<PH>& R) {
    const bf16* P = (const bf16*)(c.ws + WS_PROJ);
    const int h = task & 3, tok0 = (task >> 2) * 64;
    { const int idx = c.tid * 2, j = idx >> 4, r = idx & 15; R.al = *(const unsigned*)(P + POFF(tok0 + j, C_GA) + r); }
#pragma unroll
    for (int jj = 0; jj < 8; ++jj) { const size_t ro = (size_t)(tok0 + c.wave * 8 + jj) * 256 + h * 64 + c.lane;
        R.k[jj] = P[ro + POFF(0, C_GK)]; R.v[jj] = P[ro + POFF(0, C_GV)];
        if (PH == 3) { R.q[jj] = P[ro + POFF(0, C_GQ)]; R.r[jj] = P[ro + POFF(0, C_GR)]; R.st[jj] = ((const float*)(c.ws + WS_GSLOC))[(size_t)task * 4096 + (c.wave * 8 + jj) * 64 + c.lane]; } }
}
__device__ __forceinline__ void gla_decay(const Ctx& c, unsigned alw, const GlaW& W, GlaCommon& gc) {
    LAS float* AL = (LAS float*)(c.lds + GL_AL); LAS float* PART = (LAS float*)(c.lds + GL_PART);
    { const int idx = c.tid * 2; AL[idx] = bflo(alw); AL[idx + 1] = bfhi(alw); }
    lds_barrier();
    float run = 0.f;
    f32x4 alc[4];
#pragma unroll
    for (int r4 = 0; r4 < 4; ++r4) alc[r4] = *(const LAS f32x4*)(AL + (c.wave * 8) * 16 + 4 * r4);
#pragma unroll
    for (int jj = 0; jj < 8; ++jj) { float z = W.ab;
        f32x4 aln[4];
        if (jj < 7) {
#pragma unroll
            for (int r4 = 0; r4 < 4; ++r4) aln[r4] = *(const LAS f32x4*)(AL + (c.wave * 8 + jj + 1) * 16 + 4 * r4); }
        __builtin_amdgcn_sched_barrier(0);
#pragma unroll
        for (int r4 = 0; r4 < 4; ++r4) { const f32x4 al = alc[r4]; z += al.x * W.au[4 * r4] + al.y * W.au[4 * r4 + 1] + al.z * W.au[4 * r4 + 2] + al.w * W.au[4 * r4 + 3]; }
        const float ls = fminf(z, 0.f) - 0.69314718056f * __builtin_amdgcn_logf(1.f + __expf(-fabsf(z)));
        run += ls * (1.f / 16.f); gc.bc[jj] = run;
        if (jj < 7) {
#pragma unroll
            for (int r4 = 0; r4 < 4; ++r4) alc[r4] = aln[r4]; }
        __builtin_amdgcn_sched_barrier(0); }
    PART[c.wave * 64 + c.lane] = run;
    lds_barrier();
    float off = 0.f, tot = 0.f;
#pragma unroll
    for (int w = 0; w < 8; ++w) { const float p = PART[w * 64 + c.lane]; tot += p; if (w < c.wave) off += p; }
#pragma unroll
    for (int jj = 0; jj < 8; ++jj) gc.bc[jj] += off;
    gc.blast = tot;
}
__device__ __forceinline__ f32x4 mma2(const LAS bf16* Ab, const LAS bf16* Bb, int lane, f32x4 acc) {
    const int fr = lane & 15, fq = lane >> 4;
#pragma unroll
    for (int ks = 0; ks < 2; ++ks) { const bf16x8 av = *(const LAS bf16x8*)(Ab + fr * 72 + 32 * ks + 8 * fq), bv = *(const LAS bf16x8*)(Bb + fr * 72 + 32 * ks + 8 * fq);
        acc = __builtin_amdgcn_mfma_f32_16x16x32_bf16(av, bv, acc, 0, 0, 0); }
    return acc;
}
__device__ __forceinline__ void gla1_compute(const Ctx& c, int task, const GlaRaw<1>& R, const GlaW& W) {
    GlaCommon gc; gla_decay(c, R.al, W, gc);
    LAS bf16* KET = (LAS bf16*)(c.lds + GL_KET); LAS bf16* VT = (LAS bf16*)(c.lds + GL_VT);
    unsigned kp[4], vp[4];
#pragma unroll
    for (int jj = 0; jj < 8; jj += 2) {
        const float k0 = bf2f(R.k[jj]) * __expf(gc.blast - gc.bc[jj]), k1 = bf2f(R.k[jj + 1]) * __expf(gc.blast - gc.bc[jj + 1]);
        kp[jj >> 1] = pk2(k0, k1); vp[jj >> 1] = R.v[jj] | (R.v[jj + 1] << 16); }
    *(LAS u32x4*)(KET + c.lane * 72 + c.wave * 8) = (u32x4){kp[0], kp[1], kp[2], kp[3]};
    *(LAS u32x4*)(VT + c.lane * 72 + c.wave * 8) = (u32x4){vp[0], vp[1], vp[2], vp[3]};
    if (c.wave == 0) ((float*)(c.ws + WS_GDEC))[(size_t)task * 64 + c.lane] = __expf(gc.blast);
    lds_barrier();
    float* Sl = (float*)(c.ws + WS_GSLOC) + (size_t)task * 4096;
    const int eb = c.wave >> 1, fr = c.lane & 15, fq = c.lane >> 4;
#pragma unroll
    for (int q = 0; q < 2; ++q) { const int db = (c.wave & 1) * 2 + q;
        f32x4 acc = {0.f, 0.f, 0.f, 0.f}; acc = mma2(VT + eb * 16 * 72, KET + db * 16 * 72, c.lane, acc);
#pragma unroll
        for (int r = 0; r < 4; ++r) Sl[(eb * 16 + 4 * fq + r) * 64 + db * 16 + fr] = acc[r]; }
    lds_barrier();
}
__device__ __forceinline__ void gla3_compute(const Ctx& c, int task, const GlaRaw<3>& R, const GlaW& W) {
    bf16* HY = (bf16*)(c.ws + WS_HY);
    const int h = task & 3, tok0 = (task >> 2) * 64;
    GlaCommon gc; gla_decay(c, R.al, W, gc);
    LAS bf16* QD = (LAS bf16*)(c.lds + GL_QD); LAS bf16* KI = (LAS bf16*)(c.lds + GL_KI); LAS bf16* VT = (LAS bf16*)(c.lds + GL_VT);
    LAS bf16* ATT = (LAS bf16*)(c.lds + GL_ATT); LAS bf16* ST = (LAS bf16*)(c.lds + GL_ST); LAS float* OF = (LAS float*)(c.lds + GL_OF);
    unsigned vp[4];
#pragma unroll
    for (int jj = 0; jj < 8; ++jj) { const int j = c.wave * 8 + jj;
        const float q = bf2f(R.q[jj]) * 0.125f * __expf(gc.bc[jj]); const float k = bf2f(R.k[jj]) * __expf(-gc.bc[jj]);
        QD[j * 72 + c.lane] = (bf16)f2bf(q); KI[j * 72 + c.lane] = (bf16)f2bf(k);
        if (jj & 1) vp[jj >> 1] |= R.v[jj] << 16; else vp[jj >> 1] = R.v[jj];
        ST[j * 72 + c.lane] = (bf16)f2bf(R.st[jj]); }
    *(LAS u32x4*)(VT + c.lane * 72 + c.wave * 8) = (u32x4){vp[0], vp[1], vp[2], vp[3]};
    lds_barrier();
    const int ib = c.wave >> 1, fr = c.lane & 15, fq = c.lane >> 4;
#pragma unroll
    for (int q = 0; q < 2; ++q) { const int jb = (c.wave & 1) * 2 + q;
        f32x4 acc = {0.f, 0.f, 0.f, 0.f};
        if (jb <= ib) acc = mma2(QD + ib * 16 * 72, KI + jb * 16 * 72, c.lane, acc);
#pragma unroll
        for (int r = 0; r < 4; ++r) { const int i = ib * 16 + 4 * fq + r, j = jb * 16 + fr; ATT[i * 72 + j] = (bf16)f2bf(j <= i ? acc[r] : 0.f); } }
    lds_barrier();
#pragma unroll
    for (int q = 0; q < 2; ++q) { const int eb = (c.wave & 1) * 2 + q;
        f32x4 acc = {0.f, 0.f, 0.f, 0.f};
        acc = mma2(ATT + ib * 16 * 72, VT + eb * 16 * 72, c.lane, acc);
        acc = mma2(QD + ib * 16 * 72, ST + eb * 16 * 72, c.lane, acc);
#pragma unroll
        for (int r = 0; r < 4; ++r) OF[(ib * 16 + 4 * fq + r) * 65 + eb * 16 + fr] = acc[r]; }
    lds_barrier();
#pragma unroll
    for (int jj = 0; jj < 8; ++jj) { const int i = c.wave * 8 + jj; const float o = OF[i * 65 + c.lane];
        const float ss = wave_sum(o * o); const float rr = bf2f(R.r[jj]);
        const float y = o * (1.f / sqrtf(ss * (1.f / 64.f) + EPS)) * W.gn * (rr * sigmoidf_(rr));
        HY[(size_t)(tok0 + i) * 1024 + 256 + h * 64 + c.lane] = (bf16)f2bf(y); }
    lds_barrier();
}
template <int PH>
__device__ __forceinline__ void gla_tasks(const Args& a, const Ctx& c0, int l) {
    RELAUNDER_CTX(c0);
    GlaW W; gla_load_w(a, c, l, c.bx & 3, W);
    int task = c.bx; if (task >= 2048) return;
    GlaRaw<PH> cur; gla_load<PH>(c, task, cur);
#pragma unroll 1
    for (; task < 2048; task += c.G) {
        const int tn = task + c.G; GlaRaw<PH> nxt; gla_load<PH>(c, tn < 2048 ? tn : task, nxt);
        if (c.G & 3) gla_load_w(a, c, l, task & 3, W);
        if (PH == 1) gla1_compute(c, task, (const GlaRaw<1>&)cur, W); else gla3_compute(c, task, (const GlaRaw<3>&)cur, W);
        cur = nxt;
    }
}
__device__ __forceinline__ void gla2_phase(const Args& a, const Ctx& c) {
    float* Sl = (float*)(c.ws + WS_GSLOC); const float* dec = (const float*)(c.ws + WS_GDEC);
    for (int ch = c.bx * NTHR + c.tid; ch < BATCH * 4 * 4096; ch += c.G * NTHR) {
        const int ed = ch & 4095, bh = ch >> 12, b = bh >> 2, h = bh & 3, d = ed & 63;
        float st = 0.f;
#pragma unroll 1
        for (int n0 = 0; n0 < 64; n0 += 32) {
            float sv[32], dv[32];
#pragma unroll
            for (int n = 0; n < 32; ++n) { const int task = (b * 64 + n0 + n) * 4 + h; dv[n] = dec[(size_t)task * 64 + d]; sv[n] = Sl[(size_t)task * 4096 + ed]; }
#pragma unroll
            for (int n = 0; n < 32; ++n) { const int task = (b * 64 + n0 + n) * 4 + h; Sl[(size_t)task * 4096 + ed] = st; st = st * dv[n] + sv[n]; }
        }
    }
}
__device__ __forceinline__ void s5_1_unit(const Args& a, const Ctx& c0, int l, int unit) {
    RELAUNDER_CTX(c0);
    const int g = unit & 15, nb = unit >> 4;
    const bf16* P = (const bf16*)(c.ws + WS_PROJ);
    const bf16* We = (const bf16*)(c.ws + WS_WNM + (size_t)l * WN_LAYER + WN_S5E) + (size_t)g * 128 * 256;
    LAS bf16* WB = (LAS bf16*)c.lds;
    __syncthreads();
#pragma unroll
    for (int i = 0; i < 8; ++i) { const int idx = c.tid + NTHR * i, q = idx >> 5, kk = (idx & 31) * 8; *(LAS u32x4*)(WB + q * 264 + kk) = *(const u32x4*)(We + (size_t)q * 256 + kk); }
    __syncthreads();
    const int fr = c.lane & 15, fq = c.lane >> 4;
    const int n = nb * 128 + c.wave * 16 + fr;
    bf16x8 af[8];
#pragma unroll
    for (int ks = 0; ks < 8; ++ks) { const int s = 2 * ks + (fq >> 1), c0 = 8 * (fq & 1); af[ks] = *(const bf16x8*)(P + POFF(16 * n + s, C_SU) + 16 * g + c0); }
    float* XE = (float*)(c.ws + WS_XE);
#pragma unroll
    for (int qb = 0; qb < 8; ++qb) { f32x4 acc = {0.f, 0.f, 0.f, 0.f};
#pragma unroll
        for (int ks = 0; ks < 8; ++ks) { const bf16x8 bv = *(const LAS bf16x8*)(WB + (16 * qb + fr) * 264 + 32 * ks + 8 * fq); acc = __builtin_amdgcn_mfma_f32_16x16x32_bf16(af[ks], bv, acc, 0, 0, 0); }
#pragma unroll
        for (int r = 0; r < 4; ++r) XE[((size_t)(nb * 128 + c.wave * 16 + 4 * fq + r) * 16 + g) * 128 + 16 * qb + fr] = acc[r]; }
}
__device__ __forceinline__ void s5_2_phase(const Args& a, const Ctx& c, int l) {
    const float* XE = (const float*)(c.ws + WS_XE); bf16* XP = (bf16*)(c.ws + WS_XP);
    const f32x2* LL = (const f32x2*)(c.ws + WS_LAML) + l * 1024;
    LAS f32x2* CE = (LAS f32x2*)(c.lds);
    for (int bg = c.bx; bg < BATCH * 16; bg += c.G) {
        const int b = bg >> 4, g = bg & 15, p = c.lane; const f32x2 lm = LL[g * 64 + p];
        const size_t base0 = ((size_t)(b * 256 + 32 * c.wave) * 16 + g) * 128;
        float er[32], ei[32];
#pragma unroll
        for (int i = 0; i < 32; ++i) { er[i] = XE[base0 + (size_t)i * 2048 + p]; ei[i] = XE[base0 + (size_t)i * 2048 + 64 + p]; }
        float xr = 0.f, xi = 0.f;
#pragma unroll
        for (int i = 0; i < 32; ++i) { const float nr = lm.x * xr - lm.y * xi + er[i], ni = lm.x * xi + lm.y * xr + ei[i]; xr = nr; xi = ni; }
        CE[c.wave * 64 + p] = (f32x2){xr, xi};
        float pr = lm.x, pi = lm.y;
#pragma unroll
        for (int q = 0; q < 5; ++q) { const float nr = pr * pr - pi * pi, ni = 2.f * pr * pi; pr = nr; pi = ni; }
        __syncthreads();
        float sr = 0.f, si = 0.f;
        for (int u = 0; u < c.wave; ++u) { const f32x2 e = CE[u * 64 + p]; const float nr = pr * sr - pi * si + e.x, ni = pr * si + pi * sr + e.y; sr = nr; si = ni; }
        xr = sr; xi = si;
#pragma unroll
        for (int i = 0; i < 32; ++i) { XP[base0 + (size_t)i * 2048 + p] = (bf16)f2bf(xr); XP[base0 + (size_t)i * 2048 + 64 + p] = (bf16)f2bf(xi);
            const float nr = lm.x * xr - lm.y * xi + er[i], ni = lm.x * xi + lm.y * xr + ei[i]; xr = nr; xi = ni; }
        __syncthreads();
    }
}
__device__ __forceinline__ float gelu_tanh(float x) { const float u = 0.7978845608028654f * (x + 0.044715f * x * x * x); const float e = __expf(2.f * u); const float th = 1.f - 2.f * __builtin_amdgcn_rcpf(e + 1.f); return 0.5f * x * (1.f + th); }
__device__ __forceinline__ void s5_3_unit(const Args& a, const Ctx& c0, int l, int unit) {
    RELAUNDER_CTX(c0);
    const int g = unit & 15, nb = (unit >> 4) & 7, nh = unit >> 7;
    const bf16* P = (const bf16*)(c.ws + WS_PROJ); const bf16* XP = (const bf16*)(c.ws + WS_XP); bf16* YP = (bf16*)(c.ws + WS_YPRE);
    const bf16* Bc = (const bf16*)(c.ws + WS_WNM + (size_t)l * WN_LAYER + WN_S5B) + ((size_t)g * 256 + 128 * nh) * 384;
    LAS bf16* BB = (LAS bf16*)c.lds;
    __syncthreads();
#pragma unroll
    for (int i = 0; i < 12; ++i) { const int idx = c.tid + NTHR * i, q = idx / 48, kk = (idx % 48) * 8; *(LAS u32x4*)(BB + q * 392 + kk) = *(const u32x4*)(Bc + (size_t)q * 384 + kk); }
    __syncthreads();
    const int fr = c.lane & 15, fq = c.lane >> 4;
    f32x4 acc[2][8];
#pragma unroll
    for (int mi = 0; mi < 2; ++mi)
#pragma unroll
        for (int cb = 0; cb < 8; ++cb) acc[mi][cb] = (f32x4){0.f, 0.f, 0.f, 0.f};
    const int nrow0 = nb * 256 + c.wave * 32;
#pragma unroll
    for (int ks = 0; ks < 12; ++ks) {
        bf16x8 af[2];
#pragma unroll
        for (int mi = 0; mi < 2; ++mi) { const int n = nrow0 + 16 * mi + fr;
            if (ks < 8) { const int s = 2 * ks + (fq >> 1), c0 = 8 * (fq & 1); af[mi] = *(const bf16x8*)(P + POFF(16 * n + s, C_SU) + 16 * g + c0); }
            else af[mi] = *(const bf16x8*)(XP + ((size_t)n * 16 + g) * 128 + 32 * (ks - 8) + 8 * fq); }
#pragma unroll
        for (int cb = 0; cb < 8; ++cb) { const bf16x8 bv = *(const LAS bf16x8*)(BB + (16 * cb + fr) * 392 + 32 * ks + 8 * fq);
#pragma unroll
            for (int mi = 0; mi < 2; ++mi) acc[mi][cb] = __builtin_amdgcn_mfma_f32_16x16x32_bf16(af[mi], bv, acc[mi][cb], 0, 0, 0); }
    }
    const float dsk = a.in[I_S5_D + c.z][l * 256 + 16 * g + fr];
    unsigned uv[2][8][4];
#pragma unroll
    for (int mi = 0; mi < 2; ++mi)
#pragma unroll
        for (int cb = 0; cb < 8; ++cb)
#pragma unroll
            for (int r = 0; r < 4; ++r) { const int n = nrow0 + 16 * mi + 4 * fq + r; const size_t tok = (size_t)16 * n + 8 * nh + cb; uv[mi][cb][r] = P[POFF(tok, C_SU) + 16 * g + fr]; }
    __builtin_amdgcn_sched_barrier(0);
#pragma unroll
    for (int mi = 0; mi < 2; ++mi)
#pragma unroll
        for (int cb = 0; cb < 8; ++cb)
#pragma unroll
            for (int r = 0; r < 4; ++r) { const int n = nrow0 + 16 * mi + 4 * fq + r; const size_t tok = (size_t)16 * n + 8 * nh + cb;
                const float u = bf2f(uv[mi][cb][r]); const float y = acc[mi][cb][r] + dsk * u;
                YP[tok * 256 + 16 * g + fr] = (bf16)f2bf(gelu_tanh(y)); }
}

constexpr int DS_CAP = 2048, DS_FIRST = 1024;
constexpr int DS_BUF = 0;
constexpr int DS_HIST = 131072;
constexpr int DS_CNT = DS_HIST + 8192;
__device__ __forceinline__ float fmax_f(float a, float b) { return __builtin_amdgcn_fmed3f(a, b, 3.3e38f); }
__device__ __forceinline__ float relu_f(float a) { return __builtin_amdgcn_fmed3f(a, 0.f, 3.3e38f); }
__device__ __forceinline__ unsigned okey(float f) { const unsigned u = __float_as_uint(f); return (u & 0x80000000u) ? ~u : (u | 0x80000000u); }

__device__ __forceinline__ unsigned select_top(LAS unsigned* buf, int n, int keep, LAS unsigned* hist, int lane) {
    unsigned x[32];
#pragma unroll
    for (int i = 0; i < 32; ++i) x[i] = (64 * i + lane < n) ? buf[64 * i + lane] : 0u;
    unsigned prefix = 0u, mask = 0u; int kth = keep;
    unsigned av = ~0u, ov = 0u;
#pragma unroll
    for (int i = 0; i < 32; ++i) if (x[i] != 0u) { av &= x[i]; ov |= x[i]; }
    { unsigned t;
      t = DPP_U(av, av, 0x128); av &= t; t = DPP_U(av, av, 0x124); av &= t; t = DPP_U(av, av, 0x122); av &= t; t = DPP_U(av, av, 0x121); av &= t;
      t = DPP_U(ov, ov, 0x128); ov |= t; t = DPP_U(ov, ov, 0x124); ov |= t; t = DPP_U(ov, ov, 0x122); ov |= t; t = DPP_U(ov, ov, 0x121); ov |= t;
      av = (unsigned)__builtin_amdgcn_readlane((int)av, 0) & (unsigned)__builtin_amdgcn_readlane((int)av, 16) & (unsigned)__builtin_amdgcn_readlane((int)av, 32) & (unsigned)__builtin_amdgcn_readlane((int)av, 48);
      ov = (unsigned)__builtin_amdgcn_readlane((int)ov, 0) | (unsigned)__builtin_amdgcn_readlane((int)ov, 16) | (unsigned)__builtin_amdgcn_readlane((int)ov, 32) | (unsigned)__builtin_amdgcn_readlane((int)ov, 48); }
    const unsigned diff = av ^ ov;
#pragma unroll
    for (int pass = 0; pass < 4; ++pass) {
        const int shift = 24 - 8 * pass;
        if (((diff >> shift) & 255u) == 0u) { prefix |= av & (255u << shift); mask |= 255u << shift; continue; }
        hist[4 * lane] = 0u; hist[4 * lane + 1] = 0u; hist[4 * lane + 2] = 0u; hist[4 * lane + 3] = 0u;
        asm volatile("s_waitcnt lgkmcnt(0)" ::: "memory");
#pragma unroll
        for (int i = 0; i < 32; ++i) if (64 * i < n) { if (x[i] != 0u && (x[i] & mask) == prefix) __hip_atomic_fetch_add(hist + ((x[i] >> shift) & 255u), 1u, __ATOMIC_RELAXED, __HIP_MEMORY_SCOPE_WORKGROUP); }
        asm volatile("s_waitcnt lgkmcnt(0)" ::: "memory");
        u32x4 hv; hv.x = hist[252 - 4 * lane]; hv.y = hist[253 - 4 * lane]; hv.z = hist[254 - 4 * lane]; hv.w = hist[255 - 4 * lane];
        asm volatile("s_waitcnt lgkmcnt(0)" ::: "memory");
        const unsigned s = hv.x + hv.y + hv.z + hv.w;
        unsigned incl = s;
#pragma unroll
        for (int o = 1; o < 64; o <<= 1) { const unsigned t = __shfl_up(incl, o); if (lane >= o) incl += t; }
        const unsigned long long bal = __ballot(incl >= (unsigned)kth);
        const int L = __ffsll((long long)bal) - 1;
        unsigned cexc = incl - s, digit, above;
        if (cexc + hv.w >= (unsigned)kth) { digit = 255u - 4u * lane; above = cexc; }
        else { cexc += hv.w; if (cexc + hv.z >= (unsigned)kth) { digit = 254u - 4u * lane; above = cexc; }
            else { cexc += hv.z; if (cexc + hv.y >= (unsigned)kth) { digit = 253u - 4u * lane; above = cexc; } else { cexc += hv.y; digit = 252u - 4u * lane; above = cexc; } } }
        digit = __shfl(digit, L); above = __shfl(above, L);
        prefix |= digit << shift; mask |= 255u << shift; kth -= (int)above;
    }
    const unsigned thr = prefix;
    int base = 0;
#pragma unroll
    for (int i = 0; i < 32; ++i) if (64 * i < n) {
        const bool k = x[i] >= thr && x[i] != 0u; const unsigned long long m = __ballot(k);
        const int pos = base + (int)__builtin_amdgcn_mbcnt_hi((unsigned)(m >> 32), __builtin_amdgcn_mbcnt_lo((unsigned)m, 0u));
        if (k) buf[pos] = x[i];
        base += __popcll(m);
    }
    return thr;
}

__device__ __forceinline__ unsigned select_top2(LAS unsigned* buf, int n, int keep, int lane) {
    LAS unsigned* hist = buf + 1024;
    unsigned x[16];
#pragma unroll
    for (int i = 0; i < 16; ++i) x[i] = (64 * i + lane < n) ? buf[64 * i + lane] : 0u;
    unsigned av = ~0u, ov = 0u;
#pragma unroll
    for (int i = 0; i < 16; ++i) if (x[i] != 0u) { av &= x[i]; ov |= x[i]; }
#pragma unroll
    for (int o = 1; o < 64; o <<= 1) { av &= (unsigned)__shfl_xor((int)av, o); ov |= (unsigned)__shfl_xor((int)ov, o); }
    const unsigned diff = (av ^ ov) >> 12;
    const int hi = diff ? 32 - __clz(diff) : 0;
    int hb = hi + 12;
    unsigned mask = (hb >= 32) ? 0u : ~((1u << hb) - 1u), prefix = av & mask; int kth = keep;
    asm volatile("s_waitcnt lgkmcnt(0)" ::: "memory");
#pragma unroll 1
    while (hb > 0) {
        int w = (hb > 12) ? hb - 12 : hb; if (w > 10) w -= 10;
        const int shift = hb - w; const unsigned dm = (1u << w) - 1u;
#pragma unroll
        for (int j = 0; j < 4; ++j) { unsigned z0_ = 0u; asm volatile("" : "+v"(z0_)); *(LAS u32x4*)(hist + 16 * lane + 4 * j) = (u32x4){z0_, z0_, z0_, z0_}; }
        asm volatile("s_waitcnt lgkmcnt(0)" ::: "memory");
#pragma unroll
        for (int i = 0; i < 16; ++i) if (64 * i < n) { if (x[i] != 0u && (x[i] & mask) == prefix) __hip_atomic_fetch_add(hist + ((x[i] >> shift) & dm), 1u, __ATOMIC_RELAXED, __HIP_MEMORY_SCOPE_WORKGROUP); }
        asm volatile("s_waitcnt lgkmcnt(0)" ::: "memory");
        unsigned b[16];
#pragma unroll
        for (int j = 0; j < 4; ++j) { const u32x4 hv = *(const LAS u32x4*)(hist + 1008 - 16 * lane + 4 * j); b[4 * j] = hv.x; b[4 * j + 1] = hv.y; b[4 * j + 2] = hv.z; b[4 * j + 3] = hv.w; }
        asm volatile("s_waitcnt lgkmcnt(0)" ::: "memory");
        unsigned s = 0u;
#pragma unroll
        for (int j = 0; j < 16; ++j) s += b[j];
        unsigned incl = s;
#pragma unroll
        for (int o = 1; o < 64; o <<= 1) { const unsigned t = __shfl_up(incl, o); if (lane >= o) incl += t; }
        const unsigned long long bal = __ballot(incl >= (unsigned)kth);
        const int L = __ffsll((long long)bal) - 1;
        unsigned cexc = incl - s, digit = 0u, above = 0u, m = 0u; bool found = false;
#pragma unroll
        for (int j = 15; j >= 0; --j) { if (!found) { if (cexc + b[j] >= (unsigned)kth) { digit = (unsigned)(1008 - 16 * lane + j); above = cexc; m = b[j]; found = true; } else cexc += b[j]; } }
        digit = __shfl(digit, L); above = __shfl(above, L); m = __shfl(m, L);
        prefix |= digit << shift; mask |= dm << shift; kth -= (int)above; hb = shift;
        if ((unsigned)kth == m) break;
    }
    const unsigned thr = prefix;
    int base = 0;
#pragma unroll
    for (int i = 0; i < 16; ++i) if (64 * i < n) {
        const bool k = x[i] >= thr && x[i] != 0u; const unsigned long long mm = __ballot(k);
        const int pos = base + (int)__builtin_amdgcn_mbcnt_hi((unsigned)(mm >> 32), __builtin_amdgcn_mbcnt_lo((unsigned)mm, 0u));
        if (k) buf[pos] = x[i];
        base += __popcll(mm);
    }
    asm volatile("s_waitcnt lgkmcnt(0)" ::: "memory");
    return thr;
}
#ifndef DPP_U
#define DPP_U(v, old, ctrl) ((unsigned)__builtin_amdgcn_update_dpp((int)(old), (int)(v), (ctrl), 0xF, 0xF, false))
#endif
__device__ __forceinline__ unsigned wave_min_u(unsigned v) {
    unsigned t;
    t = DPP_U(v, v, 0x128); v = v < t ? v : t; t = DPP_U(v, v, 0x124); v = v < t ? v : t; t = DPP_U(v, v, 0x122); v = v < t ? v : t; t = DPP_U(v, v, 0x121); v = v < t ? v : t;
    const unsigned r0 = (unsigned)__builtin_amdgcn_readlane((int)v, 0), r1 = (unsigned)__builtin_amdgcn_readlane((int)v, 16), r2 = (unsigned)__builtin_amdgcn_readlane((int)v, 32), r3 = (unsigned)__builtin_amdgcn_readlane((int)v, 48);
    const unsigned a = r0 < r1 ? r0 : r1, b = r2 < r3 ? r2 : r3; return a < b ? a : b;
}
__device__ __forceinline__ unsigned wave_max_u(unsigned v) {
    unsigned t;
    t = DPP_U(v, v, 0x128); v = v > t ? v : t; t = DPP_U(v, v, 0x124); v = v > t ? v : t; t = DPP_U(v, v, 0x122); v = v > t ? v : t; t = DPP_U(v, v, 0x121); v = v > t ? v : t;
    const unsigned r0 = (unsigned)__builtin_amdgcn_readlane((int)v, 0), r1 = (unsigned)__builtin_amdgcn_readlane((int)v, 16), r2 = (unsigned)__builtin_amdgcn_readlane((int)v, 32), r3 = (unsigned)__builtin_amdgcn_readlane((int)v, 48);
    const unsigned a = r0 > r1 ? r0 : r1, b = r2 > r3 ? r2 : r3; return a > b ? a : b;
}
__device__ __forceinline__ unsigned wave_incl_scan_u(unsigned v, int lane) {
    v += DPP_U(v, 0u, 0x111); v += DPP_U(v, 0u, 0x112); v += DPP_U(v, 0u, 0x114); v += DPP_U(v, 0u, 0x118);
    const unsigned t0 = (unsigned)__builtin_amdgcn_readlane((int)v, 15), t1 = (unsigned)__builtin_amdgcn_readlane((int)v, 31), t2 = (unsigned)__builtin_amdgcn_readlane((int)v, 47);
    const unsigned add = lane >= 48 ? t0 + t1 + t2 : (lane >= 32 ? t0 + t1 : (lane >= 16 ? t0 : 0u));
    return v + add;
}
__device__ __forceinline__ float key2f(unsigned p) { const unsigned u = p & 0xFFFFF000u; return __uint_as_float((u & 0x80000000u) ? (u ^ 0x80000000u) : ~u); }
__device__ __forceinline__ unsigned select_lin(LAS unsigned* buf, int n, int keep, int lane, const bool dry = false) {
    LAS unsigned* hist = buf + 1024;
    unsigned x[16];
#pragma unroll
    for (int i = 0; i < 16; ++i) x[i] = (64 * i + lane < n) ? buf[64 * i + lane] : 0u;
    unsigned kmin = ~0u, kmax = 0u;
#pragma unroll
    for (int i = 0; i < 16; ++i) if (x[i] != 0u) { kmin = kmin < x[i] ? kmin : x[i]; kmax = kmax > x[i] ? kmax : x[i]; }
    kmin = wave_min_u(kmin); kmax = wave_max_u(kmax);
    const float lo = key2f(kmin), hv_ = key2f(kmax);
    const float scale = (hv_ > lo) ? 1023.f / (hv_ - lo) : 0.f;
    int bk[16];
#pragma unroll
    for (int i = 0; i < 16; ++i) { int q = (int)((key2f(x[i]) - lo) * scale); q = q > 1023 ? 1023 : q; q = q < 0 ? 0 : q; bk[i] = (x[i] != 0u) ? q : -1; }
#pragma unroll
    for (int j = 0; j < 4; ++j) { unsigned z0_ = 0u; asm volatile("" : "+v"(z0_)); *(LAS u32x4*)(hist + 16 * lane + 4 * j) = (u32x4){z0_, z0_, z0_, z0_}; }
    asm volatile("s_waitcnt lgkmcnt(0)" ::: "memory");
#pragma unroll
    for (int i = 0; i < 16; ++i) if (64 * i < n) { if (bk[i] >= 0) __hip_atomic_fetch_add(hist + bk[i], 1u, __ATOMIC_RELAXED, __HIP_MEMORY_SCOPE_WORKGROUP); }
    asm volatile("s_waitcnt lgkmcnt(0)" ::: "memory");
    unsigned b[16];
#pragma unroll
    for (int j = 0; j < 4; ++j) { const u32x4 hv = *(const LAS u32x4*)(hist + 1008 - 16 * lane + 4 * j); b[4 * j] = hv.x; b[4 * j + 1] = hv.y; b[4 * j + 2] = hv.z; b[4 * j + 3] = hv.w; }
    asm volatile("s_waitcnt lgkmcnt(0)" ::: "memory");
    unsigned s = 0u;
#pragma unroll
    for (int j = 0; j < 16; ++j) s += b[j];
    const unsigned incl = wave_incl_scan_u(s, lane);
    const unsigned long long bal = __ballot(incl >= (unsigned)keep);
    const int L = __ffsll((long long)bal) - 1;
    unsigned cexc = incl - s, digit = 0u, above = 0u, m = 0u; bool found = false;
#pragma unroll
    for (int j = 15; j >= 0; --j) { if (!found) { if (cexc + b[j] >= (unsigned)keep) { digit = (unsigned)(1008 - 16 * lane + j); above = cexc; m = b[j]; found = true; } else cexc += b[j]; } }
    digit = (unsigned)__builtin_amdgcn_readlane((int)digit, L); above = (unsigned)__builtin_amdgcn_readlane((int)above, L); m = (unsigned)__builtin_amdgcn_readlane((int)m, L);
    const int bstar = (int)digit, kth2 = keep - (int)above, mt = (int)m;
    int base = 0;
#pragma unroll
    for (int i = 0; i < 16; ++i) if (64 * i < n) {
        const bool td = bk[i] == bstar; const unsigned long long mm = __ballot(td);
        const int pos = base + (int)__builtin_amdgcn_mbcnt_hi((unsigned)(mm >> 32), __builtin_amdgcn_mbcnt_lo((unsigned)mm, 0u));
        if (td) hist[pos] = x[i];
        base += __popcll(mm);
    }
    asm volatile("s_waitcnt lgkmcnt(0)" ::: "memory");
    unsigned cnt[16];
#pragma unroll
    for (int i = 0; i < 16; ++i) cnt[i] = 0u;
#pragma unroll 1
    for (int j = 0; j < mt; ++j) { const unsigned t = hist[j];
#pragma unroll
        for (int i = 0; i < 16; ++i) cnt[i] += (t > x[i]) ? 1u : 0u; }
    asm volatile("s_waitcnt lgkmcnt(0)" ::: "memory");
    bool kp[16];
#pragma unroll
    for (int i = 0; i < 16; ++i) { kp[i] = bk[i] > bstar || (bk[i] == bstar && (int)cnt[i] < kth2); if (bk[i] == bstar && (int)cnt[i] == kth2 - 1) hist[1023] = x[i]; }
    asm volatile("s_waitcnt lgkmcnt(0)" ::: "memory");
    const unsigned thr = hist[1023];
    base = 0;
#pragma unroll
    for (int i = 0; i < 16; ++i) if (64 * i < n) {
        const unsigned long long mm = __ballot(kp[i]);
        const int pos = base + (int)__builtin_amdgcn_mbcnt_hi((unsigned)(mm >> 32), __builtin_amdgcn_mbcnt_lo((unsigned)mm, 0u));
        if (kp[i]) { if (!dry) buf[pos] = x[i]; else hist[pos & 1023] = x[i]; }
        base += __popcll(mm);
    }
    asm volatile("s_waitcnt lgkmcnt(0)" ::: "memory");
    return thr;
}
__device__ __forceinline__ unsigned select_lin_loose(LAS unsigned* buf, int n, int keep, int lane, int& kept, const bool dry = false) {
    LAS unsigned* hist = buf + 1024;
    unsigned x[16];
#pragma unroll
    for (int i = 0; i < 16; ++i) x[i] = (64 * i + lane < n) ? buf[64 * i + lane] : 0u;
    unsigned kmin = ~0u, kmax = 0u;
#pragma unroll
    for (int i = 0; i < 16; ++i) if (x[i] != 0u) { kmin = kmin < x[i] ? kmin : x[i]; kmax = kmax > x[i] ? kmax : x[i]; }
    kmin = wave_min_u(kmin); kmax = wave_max_u(kmax);
    const float lo = key2f(kmin), hv_ = key2f(kmax);
    const float scale = (hv_ > lo) ? 1023.f / (hv_ - lo) : 0.f;
    int bk[16];
#pragma unroll
    for (int i = 0; i < 16; ++i) { int q = (int)((key2f(x[i]) - lo) * scale); q = q > 1023 ? 1023 : q; q = q < 0 ? 0 : q; bk[i] = (x[i] != 0u) ? q : -1; }
#pragma unroll
    for (int j = 0; j < 4; ++j) { unsigned z0_ = 0u; asm volatile("" : "+v"(z0_)); *(LAS u32x4*)(hist + 16 * lane + 4 * j) = (u32x4){z0_, z0_, z0_, z0_}; }
    asm volatile("s_waitcnt lgkmcnt(0)" ::: "memory");
#pragma unroll
    for (int i = 0; i < 16; ++i) if (64 * i < n) { if (bk[i] >= 0) __hip_atomic_fetch_add(hist + bk[i], 1u, __ATOMIC_RELAXED, __HIP_MEMORY_SCOPE_WORKGROUP); }
    asm volatile("s_waitcnt lgkmcnt(0)" ::: "memory");
    unsigned b[16];
#pragma unroll
    for (int j = 0; j < 4; ++j) { const u32x4 hv = *(const LAS u32x4*)(hist + 1008 - 16 * lane + 4 * j); b[4 * j] = hv.x; b[4 * j + 1] = hv.y; b[4 * j + 2] = hv.z; b[4 * j + 3] = hv.w; }
    asm volatile("s_waitcnt lgkmcnt(0)" ::: "memory");
    unsigned s = 0u;
#pragma unroll
    for (int j = 0; j < 16; ++j) s += b[j];
    const unsigned incl = wave_incl_scan_u(s, lane);
    const unsigned long long bal = __ballot(incl >= (unsigned)keep);
    const int L = __ffsll((long long)bal) - 1;
    unsigned cexc = incl - s, digit = 0u, above = 0u, m = 0u; bool found = false;
#pragma unroll
    for (int j = 15; j >= 0; --j) { if (!found) { if (cexc + b[j] >= (unsigned)keep) { digit = (unsigned)(1008 - 16 * lane + j); above = cexc; m = b[j]; found = true; } else cexc += b[j]; } }
    digit = (unsigned)__builtin_amdgcn_readlane((int)digit, L); above = (unsigned)__builtin_amdgcn_readlane((int)above, L); m = (unsigned)__builtin_amdgcn_readlane((int)m, L);
    const int bstar = (int)digit;
    kept = (int)(above + m);
    unsigned kminv = ~0u; int base = 0;
#pragma unroll
    for (int i = 0; i < 16; ++i) if (64 * i < n) {
        const bool kp = bk[i] >= bstar; const unsigned long long mm = __ballot(kp);
        const int pos = base + (int)__builtin_amdgcn_mbcnt_hi((unsigned)(mm >> 32), __builtin_amdgcn_mbcnt_lo((unsigned)mm, 0u));
        if (kp) { if (!dry) buf[pos] = x[i]; else hist[pos & 1023] = x[i]; kminv = kminv < x[i] ? kminv : x[i]; }
        base += __popcll(mm);
    }
    asm volatile("s_waitcnt lgkmcnt(0)" ::: "memory");
    return wave_min_u(kminv) - 1u;
}
__device__ __forceinline__ unsigned select_any(LAS unsigned* buf, int n, int keep, LAS unsigned* hist, int lane) {
    return (n <= 1024) ? select_lin(buf, n, keep, lane) : select_top(buf, n, keep, hist, lane);
}

struct DsaPF { bf16x8 qf[8]; bf16x8 ql; u32x4 w; bf16x8 kfa[4]; };
__device__ __forceinline__ void dsa_prefetch(const Ctx& c, int b, int qt, DsaPF& pf) {
    const bf16* P = (const bf16*)(c.ws + WS_PROJ);
    const int t0 = qt * 16, nkb = qt + 1, fr = c.lane & 15, fq = c.lane >> 4; const size_t tokb = (size_t)b * SEQ;
    const int nkbA = nkb < 64 ? nkb : 64;
#pragma unroll
    for (int h = 0; h < 8; ++h) pf.qf[h] = *(const bf16x8*)(P + POFF(tokb + t0 + fr, C_IQ) + 32 * h + 8 * fq);
    pf.ql = *(const bf16x8*)(P + POFF(tokb + t0 + fr, C_IL) + 8 * fq);
    pf.w = *(const u32x4*)(P + POFF(tokb + t0 + fr, C_IW));
#pragma unroll
    for (int u = 0; u < 4; ++u) { const int kb = c.wave + 8 * u; pf.kfa[u] = *(const bf16x8*)(P + POFF(tokb + (kb < nkbA ? kb : 0) * 16 + fr, C_IK) + 8 * fq); }
}
template <int DO_ATT>
__device__ __forceinline__ void dsa_tile(const Args& a, const Ctx& c0, int b, int qt, int nb_, int nqt, DsaPF& pf, unsigned* qctr = nullptr, LAS int* nxslot = nullptr) {
    RELAUNDER_CTX(c0);
    int popped = 0;
    if (qctr && c.tid == 0) popped = (int)__hip_atomic_fetch_add(qctr, 1u, __ATOMIC_RELAXED, __HIP_MEMORY_SCOPE_AGENT);
    const bf16* P = (const bf16*)(c.ws + WS_PROJ); bf16* HY = (bf16*)(c.ws + WS_HY);
    LAS unsigned* BUF = (LAS unsigned*)(c.lds + DS_BUF); LAS unsigned* HIST = (LAS unsigned*)(c.lds + DS_HIST) + c.wave * 256;
    LAS int* CNT = (LAS int*)(c.lds + DS_CNT); LAS unsigned* THR = (LAS unsigned*)(c.lds + DS_CNT + 64);
    const int t0 = qt * 16, nkb = qt + 1, fr = c.lane & 15, fq = c.lane >> 4;
    const size_t tokb = (size_t)b * SEQ;
    lds_barrier();
    bf16x8 qf[8];
#pragma unroll
    for (int h = 0; h < 8; ++h) qf[h] = pf.qf[h];
    const bf16x8 ql = pf.ql;
    float sg[8];
    { const u32x4 w = pf.w;
      sg[0] = bflo(w.x); sg[1] = bfhi(w.x); sg[2] = bflo(w.y); sg[3] = bfhi(w.y); sg[4] = bflo(w.z); sg[5] = bfhi(w.z); sg[6] = bflo(w.w); sg[7] = bfhi(w.w); }
    const int tq = t0 + fr;
    if (c.tid < 16) { const int t = t0 + c.tid; CNT[c.tid] = (t + 1 < DS_FIRST) ? t + 1 : DS_FIRST; THR[c.tid] = 0u; }
#define DSA_LOADK(kb) (*(const bf16x8*)(P + POFF(tokb + (kb) * 16 + fr, C_IK) + 8 * fq))
#define DSA_COMPUTE(kf, kb, pk) do { \
        f32x4 sc = __builtin_amdgcn_mfma_f32_16x16x32_bf16(kf, ql, (f32x4){0.f, 0.f, 0.f, 0.f}, 0, 0, 0); \
        _Pragma("unroll") for (int h = 0; h < 8; ++h) { const f32x4 d = __builtin_amdgcn_mfma_f32_16x16x32_bf16(kf, qf[h], (f32x4){0.f, 0.f, 0.f, 0.f}, 0, 0, 0); \
            sc.x = __builtin_fmaf(sg[h], __builtin_fabsf(d.x), sc.x); sc.y = __builtin_fmaf(sg[h], __builtin_fabsf(d.y), sc.y); sc.z = __builtin_fmaf(sg[h], __builtin_fabsf(d.z), sc.z); sc.w = __builtin_fmaf(sg[h], __builtin_fabsf(d.w), sc.w); } \
        _Pragma("unroll") for (int r = 0; r < 4; ++r) { const int s = (kb) * 16 + 4 * fq + r; pk[r] = (s <= tq) ? ((okey(sc[r] + 0.f) & 0xFFFFF000u) | (unsigned)(4095 - s)) : 0u; } } while (0)
    const int nkbA = nkb < DS_FIRST / 16 ? nkb : DS_FIRST / 16;
    {
        bf16x8 kfa[4];
#ifdef PROBE_SC2
#pragma unroll 1
        for (int rep_ = 0; rep_ < 2; ++rep_) {
#endif
#pragma unroll
        for (int u = 0; u < 4; ++u) kfa[u] = pf.kfa[u];
#pragma unroll 1
        for (int kb0 = c.wave; kb0 < nkbA; kb0 += 4 * NWAVES) {
            bf16x8 kfn[4];
#pragma unroll
            for (int u = 0; u < 4; ++u) { const int kb = kb0 + 4 * NWAVES + 8 * u; kfn[u] = DSA_LOADK(kb < nkb ? kb : 0); }
#pragma unroll
            for (int u = 0; u < 4; ++u) { const int kb = kb0 + 8 * u; if (kb < nkbA && DO_ATT != 3) { unsigned pk[4]; DSA_COMPUTE(kfa[u], kb, pk);
                *(LAS u32x4*)(BUF + fr * DS_CAP + kb * 16 + 4 * fq) = (u32x4){pk[0], pk[1], pk[2], pk[3]}; }
                __builtin_amdgcn_sched_barrier(0); }
#pragma unroll
            for (int u = 0; u < 4; ++u) kfa[u] = kfn[u];
        }
#ifdef PROBE_SC2
        asm volatile("s_waitcnt lgkmcnt(0)" ::: "memory");
        }
#endif
    if (qctr && c.tid == 0) *nxslot = popped;
    lds_barrier();
#ifndef DSA_NOSEL
    if (nkb > DS_FIRST / 16) {
#pragma unroll 1
        for (int q = 0; q < 2; ++q) { const int r = c.wave + 8 * q; int kept;
#ifdef PROBE_LOOSE2
            { int k2; const unsigned t2 = select_lin_loose(BUF + r * DS_CAP, DS_FIRST, 256, c.lane, k2, true); asm volatile("" :: "v"(t2), "v"(k2)); asm volatile("s_waitcnt lgkmcnt(0)" ::: "memory"); }
#endif
            const unsigned th = select_lin_loose(BUF + r * DS_CAP, DS_FIRST, 256, c.lane, kept); if (c.lane == 0) { CNT[r] = kept; THR[r] = th; } }
        lds_barrier();
#ifdef PROBE_SB2
        {
            bf16x8 kfd[4];
#pragma unroll
            for (int i = 0; i < 4; ++i) { const int kb = DS_FIRST / 16 + c.wave + 8 * i; kfd[i] = DSA_LOADK(kb < nkb ? kb : 0); }
            unsigned dsum = 0u;
#pragma unroll 1
            for (int kb0 = DS_FIRST / 16; kb0 < nkb; kb0 += 32) {
                const unsigned th = THR[fr];
                bf16x8 kfn[4];
#pragma unroll
                for (int i = 0; i < 4; ++i) { const int kb = kb0 + 32 + c.wave + 8 * i; kfn[i] = DSA_LOADK(kb < nkb ? kb : 0); }
#pragma unroll
                for (int i = 0; i < 4; ++i) { const int kb = kb0 + c.wave + 8 * i; if (kb < nkb) { unsigned pk[4]; DSA_COMPUTE(kfd[i], kb, pk);
#pragma unroll
                        for (int r = 0; r < 4; ++r) if (pk[r] > th) dsum += pk[r]; }
                    __builtin_amdgcn_sched_barrier(0); }
#pragma unroll
                for (int i = 0; i < 4; ++i) kfd[i] = kfn[i];
                __syncthreads();
                bool need = false;
#pragma unroll
                for (int r = 0; r < 16; ++r) need = need || (CNT[r] > DS_CAP - 512);
                __syncthreads();
                if (need) dsum += 1u;
            }
            asm volatile("" :: "v"(dsum));
        }
#endif
#ifdef PROBE_SC2
#pragma unroll
        for (int i = 0; i < 4; ++i) { const int kb = DS_FIRST / 16 + c.wave + 8 * i; kfa[i] = DSA_LOADK(kb < nkb ? kb : 0); }
#endif
#pragma unroll 1
        for (int kb0 = DS_FIRST / 16; kb0 < nkb; kb0 += 32) {
            const unsigned th = THR[fr];
            bf16x8 kfn[4];
#pragma unroll
            for (int i = 0; i < 4; ++i) { const int kb = kb0 + 32 + c.wave + 8 * i; kfn[i] = DSA_LOADK(kb < nkb ? kb : 0); }
#pragma unroll
            for (int i = 0; i < 4; ++i) { const int kb = kb0 + c.wave + 8 * i; if (kb < nkb && DO_ATT != 3) { unsigned pk[4]; DSA_COMPUTE(kfa[i], kb, pk);
#pragma unroll
                    for (int r = 0; r < 4; ++r) if (pk[r] > th) { const int pos = __hip_atomic_fetch_add(&CNT[fr], 1, __ATOMIC_RELAXED, __HIP_MEMORY_SCOPE_WORKGROUP); if (pos < DS_CAP) BUF[fr * DS_CAP + pos] = pk[r]; } }
                __builtin_amdgcn_sched_barrier(0); }
#pragma unroll
            for (int i = 0; i < 4; ++i) kfa[i] = kfn[i];
            lds_barrier();
            bool need = false;
#pragma unroll
            for (int r = 0; r < 16; ++r) need = need || (CNT[r] > DS_CAP - 512);
            lds_barrier();
            if (need) {
#pragma unroll 1
                for (int q = 0; q < 2; ++q) { const int r = c.wave + 8 * q; int n = CNT[r]; n = n < DS_CAP ? n : DS_CAP;
                    if (n > 256) { const unsigned th2 = select_any(BUF + r * DS_CAP, n, 256, HIST, c.lane); if (c.lane == 0) { CNT[r] = 256; THR[r] = th2; } } }
                lds_barrier();
            }
        }
    }
#endif
    }
    if (nqt >= 0) dsa_prefetch(c, nb_, nqt, pf);
#pragma unroll 1
    for (int q = 0; q < 2; ++q) {
        const int r = c.wave + 8 * q, t = t0 + r; const size_t tok = tokb + t;
        LAS unsigned* rb = BUF + r * DS_CAP;
        int n = CNT[r]; n = n < DS_CAP ? n : DS_CAP;
#ifdef DSA_NOSEL
        if (n > 256) n = 256;
#else
#ifdef PROBE_FINAL2
        if (n > 256 && n <= 1024) { const unsigned t2 = select_lin(rb, n, 256, c.lane, true); asm volatile("" :: "v"(t2)); asm volatile("s_waitcnt lgkmcnt(0)" ::: "memory"); }
#endif
        if (n > 256) { (void)select_any(rb, n, 256, HIST, c.lane); n = 256; }
#endif
        if (nkb > DS_FIRST / 16) {
#ifdef PROBE_CANON2
#pragma unroll 1
            for (int rep_ = 0; rep_ < 2; ++rep_) {
#endif
            unsigned cv[4]; int cs_[4];
#pragma unroll
            for (int jj = 0; jj < 4; ++jj) { const int i = c.lane + 64 * jj; cv[jj] = (i < n) ? rb[i] : 0u; cs_[jj] = (int)(cv[jj] & 0xFFFu); }
            HIST[2 * c.lane] = 0u; HIST[2 * c.lane + 1] = 0u;
            asm volatile("s_waitcnt lgkmcnt(0)" ::: "memory");
#pragma unroll
            for (int jj = 0; jj < 4; ++jj) if (cv[jj] != 0u) __hip_atomic_fetch_or(HIST + (cs_[jj] >> 5), 1u << (cs_[jj] & 31), __ATOMIC_RELAXED, __HIP_MEMORY_SCOPE_WORKGROUP);
            asm volatile("s_waitcnt lgkmcnt(0)" ::: "memory");
            const unsigned w0 = HIST[2 * c.lane], w1 = HIST[2 * c.lane + 1];
            const unsigned own = (unsigned)(__popc(w0) + __popc(w1));
            const unsigned incl = wave_incl_scan_u(own, c.lane);
            asm volatile("s_waitcnt lgkmcnt(0)" ::: "memory");
            HIST[128 + 2 * c.lane] = incl - own; HIST[128 + 2 * c.lane + 1] = incl - own + (unsigned)__popc(w0);
            asm volatile("s_waitcnt lgkmcnt(0)" ::: "memory");
#pragma unroll
            for (int jj = 0; jj < 4; ++jj) if (cv[jj] != 0u) { const int wi = cs_[jj] >> 5; const unsigned bw = HIST[wi], pre = HIST[128 + wi];
                rb[pre + (unsigned)__popc(bw & ((1u << (cs_[jj] & 31)) - 1u))] = cv[jj]; }
            asm volatile("s_waitcnt lgkmcnt(0)" ::: "memory");
#ifdef PROBE_CANON2
            }
#endif
        }
        if (DO_ATT == 1 || DO_ATT == 2) {
        int ln_ = c.lane; asm volatile("" : "+v"(ln_));
        const int fr = ln_ & 15, fq = ln_ >> 4;
        {
            const unsigned first = rb[0]; u32x4 kv = *(const LAS u32x4*)(rb + 4 * ln_);
            unsigned of0 = 4095u - (first & 0xFFFu); if (DO_ATT == 2) of0 &= 15u;
#pragma unroll
            for (int e = 0; e < 4; ++e) { unsigned o = 4095u - (kv[e] & 0xFFFu); if (DO_ATT == 2) o &= 15u; kv[e] = ((4 * ln_ + e < n) ? o : of0) << 9; }
            asm volatile("s_waitcnt lgkmcnt(0)" ::: "memory");
            *(LAS u32x4*)(rb + 4 * ln_) = kv;
            asm volatile("s_waitcnt lgkmcnt(0)" ::: "memory");
        }
        typedef const __attribute__((address_space(1))) char* gptr_t;
        gptr_t kbase; gptr_t vbase;
        { const unsigned long long ka_ = (unsigned long long)(c.ws + WS_K8 + tokb * 64), va_ = (unsigned long long)(c.ws + WS_V8 + tokb * 64);
          kbase = (gptr_t)(((unsigned long long)(unsigned)__builtin_amdgcn_readfirstlane((int)(ka_ >> 32)) << 32) | (unsigned)__builtin_amdgcn_readfirstlane((int)ka_));
          vbase = (gptr_t)(((unsigned long long)(unsigned)__builtin_amdgcn_readfirstlane((int)(va_ >> 32)) << 32) | (unsigned)__builtin_amdgcn_readfirstlane((int)va_)); }
        long qb[2] = {0l, 0l};
        if (fr < 4) { const bf16x8 q0 = *(const bf16x8*)(P + POFF(tok, C_DQ) + fr * 64 + 16 * fq), q1 = *(const bf16x8*)(P + POFF(tok, C_DQ) + fr * 64 + 16 * fq + 8);
            int w0 = __builtin_amdgcn_cvt_pk_fp8_f32(8.f * bf2f((unsigned short)q0[0]), 8.f * bf2f((unsigned short)q0[1]), 0, false); w0 = __builtin_amdgcn_cvt_pk_fp8_f32(8.f * bf2f((unsigned short)q0[2]), 8.f * bf2f((unsigned short)q0[3]), w0, true);
            int w1 = __builtin_amdgcn_cvt_pk_fp8_f32(8.f * bf2f((unsigned short)q0[4]), 8.f * bf2f((unsigned short)q0[5]), 0, false); w1 = __builtin_amdgcn_cvt_pk_fp8_f32(8.f * bf2f((unsigned short)q0[6]), 8.f * bf2f((unsigned short)q0[7]), w1, true);
            int w2 = __builtin_amdgcn_cvt_pk_fp8_f32(8.f * bf2f((unsigned short)q1[0]), 8.f * bf2f((unsigned short)q1[1]), 0, false); w2 = __builtin_amdgcn_cvt_pk_fp8_f32(8.f * bf2f((unsigned short)q1[2]), 8.f * bf2f((unsigned short)q1[3]), w2, true);
            int w3 = __builtin_amdgcn_cvt_pk_fp8_f32(8.f * bf2f((unsigned short)q1[4]), 8.f * bf2f((unsigned short)q1[5]), 0, false); w3 = __builtin_amdgcn_cvt_pk_fp8_f32(8.f * bf2f((unsigned short)q1[6]), 8.f * bf2f((unsigned short)q1[7]), w3, true);
            qb[0] = (long)(((unsigned long long)(unsigned)w1 << 32) | (unsigned)w0); qb[1] = (long)(((unsigned long long)(unsigned)w3 << 32) | (unsigned)w2); }
        LAS float* LG = (LAS float*)((LAS unsigned char*)rb + 3200);
        LAS bf16* PT = (LAS bf16*)(rb + 256);
        LAS unsigned char* vb = (LAS unsigned char*)rb + 3200;
        const unsigned kvo = 16u * (unsigned)fq, vvo = 16u * (unsigned)(ln_ & 3);
        const int kloc = ln_ >> 2;
#define QK_LOAD(ka_, Q) do { _Pragma("unroll") for (int u = 0; u < 4; ++u) { const unsigned o = (rb[16 * ((Q) * 4 + u) + fr] >> 3) + kvo; ka_[u] = *(const __attribute__((address_space(1))) u32x4*)(kbase + o); } } while (0)
#define QK_MMA(ka_, Q) do { _Pragma("unroll") for (int u = 0; u < 4; ++u) { f32x4 acc = {0.f, 0.f, 0.f, 0.f}; \
                acc = __builtin_amdgcn_mfma_f32_16x16x32_fp8_fp8((long)(((unsigned long long)ka_[u].y << 32) | ka_[u].x), qb[0], acc, 0, 0, 0); \
                acc = __builtin_amdgcn_mfma_f32_16x16x32_fp8_fp8((long)(((unsigned long long)ka_[u].w << 32) | ka_[u].z), qb[1], acc, 0, 0, 0); \
                if (fr < 4) *(LAS f32x4*)(LG + fr * 272 + 16 * ((Q) * 4 + u) + 4 * fq) = acc; } } while (0)
#define PV_GATHER(dst, ks_) do { _Pragma("unroll") for (int j = 0; j < 2; ++j) { const unsigned o = (rb[32 * (ks_) + 16 * j + kloc] >> 3) + vvo; dst[j] = *(const __attribute__((address_space(1))) u32x4*)(vbase + o); } } while (0)
        const int nks = __builtin_amdgcn_readfirstlane((n + 31) >> 5);
#ifdef PROBE_QK2
        { u32x4 ka0[4], ka1[4], ka2[4];
          QK_LOAD(ka0, 0); QK_LOAD(ka1, 1); QK_LOAD(ka2, 2); QK_MMA(ka0, 0); QK_LOAD(ka0, 3); QK_MMA(ka1, 1); QK_MMA(ka2, 2); QK_MMA(ka0, 3);
          asm volatile("s_waitcnt lgkmcnt(0)" ::: "memory"); }
#endif
        u32x4 g[8][2];
        {
            u32x4 ka0[4], ka1[4], ka2[4];
            QK_LOAD(ka0, 0); QK_LOAD(ka1, 1); QK_LOAD(ka2, 2);
            PV_GATHER(g[0], 0); PV_GATHER(g[1], 1); PV_GATHER(g[2], 2); PV_GATHER(g[3], 3);
            QK_MMA(ka0, 0);
            QK_LOAD(ka0, 3);
            QK_MMA(ka1, 1); QK_MMA(ka2, 2);
            PV_GATHER(g[4], 4); PV_GATHER(g[5], 5);
            QK_MMA(ka0, 3);
            PV_GATHER(g[6], 6); PV_GATHER(g[7], 7);
        }
#undef QK_LOAD
#undef QK_MMA
        asm volatile("s_waitcnt lgkmcnt(0)" ::: "memory");
        LAS unsigned char* PT8 = (LAS unsigned char*)(rb + 256);
        float pinv = 0.f;
#ifdef PROBE_SM2
#pragma unroll 1
        for (int rep_ = 0; rep_ < 2; ++rep_)
#endif
        {
            f32x4 lv[4];
#pragma unroll
            for (int j = 0; j < 4; ++j) lv[j] = *(const LAS f32x4*)(LG + fq * 272 + 64 * j + 4 * fr);
            float mx = lv[0][0];
#pragma unroll
            for (int j = 0; j < 4; ++j)
#pragma unroll
                for (int e = 0; e < 4; ++e) mx = fmax_f(mx, lv[j][e]);
            mx = fmaxf(mx, __uint_as_float(DPP_U(__float_as_uint(mx), __float_as_uint(mx), 0x128))); mx = fmaxf(mx, __uint_as_float(DPP_U(__float_as_uint(mx), __float_as_uint(mx), 0x124)));
            mx = fmaxf(mx, __uint_as_float(DPP_U(__float_as_uint(mx), __float_as_uint(mx), 0x122))); mx = fmaxf(mx, __uint_as_float(DPP_U(__float_as_uint(mx), __float_as_uint(mx), 0x121)));
            float ssum = 0.f;
#pragma unroll
            for (int j = 0; j < 4; ++j)
#pragma unroll
                for (int e = 0; e < 4; ++e) { float p = __expf((lv[j][e] - mx) * 0.125f); p = (64 * j + 4 * fr + e < n) ? p : 0.f; lv[j][e] = p; ssum += p; }
            ssum += __uint_as_float(DPP_U(__float_as_uint(ssum), __float_as_uint(ssum), 0x128)); ssum += __uint_as_float(DPP_U(__float_as_uint(ssum), __float_as_uint(ssum), 0x124));
            ssum += __uint_as_float(DPP_U(__float_as_uint(ssum), __float_as_uint(ssum), 0x122)); ssum += __uint_as_float(DPP_U(__float_as_uint(ssum), __float_as_uint(ssum), 0x121));
            pinv = 1.f / (64.f * ssum); asm volatile("" : "+v"(pinv));
#pragma unroll
            for (int j = 0; j < 4; ++j) { int w = __builtin_amdgcn_cvt_pk_fp8_f32(64.f * lv[j][0], 64.f * lv[j][1], 0, false); w = __builtin_amdgcn_cvt_pk_fp8_f32(64.f * lv[j][2], 64.f * lv[j][3], w, true);
                *(LAS int*)(PT8 + fq * 272 + 64 * j + 4 * fr) = w; }
#ifdef PROBE_SM2
            asm volatile("s_waitcnt lgkmcnt(0)" ::: "memory");
#endif
        }
        asm volatile("s_waitcnt lgkmcnt(0)" ::: "memory");
#ifdef PROBE_PV2
#pragma unroll 1
        for (int rep_ = 0; rep_ < 2; ++rep_)
#endif
        {
            f32x4 oacc[4];
#pragma unroll
            for (int nb = 0; nb < 4; ++nb) oacc[nb] = (f32x4){0.f, 0.f, 0.f, 0.f};
            LAS unsigned char* trp = vb + (8 * fq + (fr >> 1)) * 80 + 8 * (fr & 1);
            LAS unsigned char* wrp = vb + kloc * 80 + (ln_ & 3) * 16;
#pragma unroll
            for (int ks = 0; ks < 8; ++ks) {
                if (ks < nks) {
#pragma unroll
                    for (int j = 0; j < 2; ++j) *(LAS u32x4*)(wrp + j * 16 * 80) = g[ks][j];
                    long af = 0l;
                    if (fr < 4) af = *(const LAS long*)(PT8 + fr * 272 + 32 * ks + 8 * fq);
#pragma unroll
                    for (int nb = 0; nb < 4; ++nb) {
                        typedef int i32x2 __attribute__((ext_vector_type(2)));
                        const i32x2 bv = __builtin_amdgcn_ds_read_tr8_b64_v2i32((LAS i32x2*)(trp + nb * 16));
                        oacc[nb] = __builtin_amdgcn_mfma_f32_16x16x32_fp8_fp8(af, (long)(((unsigned long long)(unsigned)bv[1] << 32) | (unsigned)bv[0]), oacc[nb], 0, 0, 0);
                    }
                }
            }
#undef PV_GATHER
            if (fq == 0) {
#pragma unroll
                for (int nb = 0; nb < 4; ++nb)
#pragma unroll
                    for (int h = 0; h < 4; ++h) HY[tok * 1024 + 768 + h * 64 + 16 * nb + fr] = (bf16)f2bf(oacc[nb][h] * __builtin_bit_cast(float, __builtin_amdgcn_readlane(__builtin_bit_cast(int, pinv), 16 * h)));
            }
        }
        }
    }
#undef DSA_COMPUTE
#undef DSA_LOADK
}
template <int DO_ATT>
__device__ __forceinline__ void dsa_phase(const Args& a, const Ctx& c, int l) {
#ifndef DSA_STATIC
    if ((c.G & 7) == 0) {
        const int b = c.bx & 7;
        unsigned* qctr = (unsigned*)(c.ws + WS_CTL) + CW_DSAQ + (l * 8 + b) * 32;
        LAS int* NX = (LAS int*)(c.lds + DS_CNT + 128);
        __syncthreads();
        if (c.tid == 0) { NX[2] = (int)__hip_atomic_fetch_add(qctr, 1u, __ATOMIC_RELAXED, __HIP_MEMORY_SCOPE_AGENT); NX[3] = (int)__hip_atomic_fetch_add(qctr, 1u, __ATOMIC_RELAXED, __HIP_MEMORY_SCOPE_AGENT); }
        __syncthreads();
        int cur = __builtin_amdgcn_readfirstlane(NX[2]), nxt = __builtin_amdgcn_readfirstlane(NX[3]);
        DsaPF pf; if (cur < 256) dsa_prefetch(c, b, 255 - cur, pf);
        for (int k = 0; cur < 256; ++k) {
            dsa_tile<DO_ATT>(a, c, b, 255 - cur, b, nxt < 256 ? 255 - nxt : -1, pf, qctr, NX + (k & 1));
            const int nn = __builtin_amdgcn_readfirstlane(NX[k & 1]);
            cur = nxt; nxt = nn;
        }
    } else
#endif
    if ((c.G & 7) == 0) {
        const int per = c.G >> 3, w = c.bx >> 3, b = c.bx & 7, nr = (256 + per - 1) / per;
        DsaPF pf; { const int idx0 = w; if (idx0 < 256) dsa_prefetch(c, b, 255 - idx0, pf); }
        for (int r = 0; r < nr; ++r) { const int idx = r * per + ((r & 1) ? per - 1 - w : w); const int idn = (r + 1) * per + (((r + 1) & 1) ? per - 1 - w : w);
            if (idx < 256) dsa_tile<DO_ATT>(a, c, b, 255 - idx, b, (r + 1 < nr && idn < 256) ? 255 - idn : -1, pf); }
    } else {
        const int nr = (2048 + c.G - 1) / c.G;
        DsaPF pf; { const int Lx0 = c.bx; if (Lx0 < 2048) dsa_prefetch(c, Lx0 & 7, 255 - (Lx0 >> 3), pf); }
        for (int r = 0; r < nr; ++r) { const int q = (r & 1) ? (c.G - 1 - c.bx) : c.bx; const int Lx = r * c.G + q; const int qn = ((r + 1) & 1) ? (c.G - 1 - c.bx) : c.bx; const int Ln = (r + 1) * c.G + qn;
            if (Lx < 2048) dsa_tile<DO_ATT>(a, c, Lx & 7, 255 - (Lx >> 3), Ln & 7, (r + 1 < nr && Ln < 2048) ? 255 - (Ln >> 3) : -1, pf); }
    }
}

constexpr int XA_K = 0, XA_VT = 69632;
__device__ __forceinline__ void xattn_compute(const Ctx& c, int l, int b, int h, int qb) {
    const bf16* Q = (const bf16*)(c.ws + WS_Q); bf16* O = (bf16*)(c.ws + WS_O);
    LAS bf16* KL = (LAS bf16*)(c.lds + XA_K); LAS bf16* VTL = (LAS bf16*)(c.lds + XA_VT);
    const int r32 = c.lane & 31, hh = c.lane >> 5;
    const size_t qrow = (size_t)b * SEQ + qb * 256 + c.wave * 32 + r32;
    bf16x8 qf[8];
#pragma unroll
    for (int ks = 0; ks < 8; ++ks) qf[ks] = *(const bf16x8*)(Q + qrow * 512 + h * 128 + 16 * ks + 8 * hh);
    f32x16 X[8];
#pragma unroll
    for (int kb = 0; kb < 8; ++kb) { f32x16 acc;
#pragma unroll
        for (int e = 0; e < 16; ++e) acc[e] = 0.f;
#pragma unroll
        for (int ks = 0; ks < 8; ++ks) { const bf16x8 kf = *(const LAS bf16x8*)(KL + (32 * kb + r32) * 136 + 16 * ks + 8 * hh); acc = __builtin_amdgcn_mfma_f32_32x32x16_bf16(kf, qf[ks], acc, 0, 0, 0); }
        X[kb] = acc; }
    float m = -3.0e38f;
#pragma unroll
    for (int kb = 0; kb < 8; ++kb)
#pragma unroll
        for (int e = 0; e < 16; ++e) m = fmax_f(m, X[kb][e]);
    m = fmaxf(m, __shfl_xor(m, 32));
    float rq;
    { const f32x4* sp = (const f32x4*)((const float*)(c.ws + WS_SSQ) + qrow * 16); const f32x4 s0 = sp[0], s1 = sp[1], s2 = sp[2], s3 = sp[3];
      const float tot = ((s0.x + s0.y) + (s0.z + s0.w)) + ((s1.x + s1.y) + (s1.z + s1.w)) + ((s2.x + s2.y) + (s2.z + s2.w)) + ((s3.x + s3.y) + (s3.z + s3.w));
      rq = 1.f / sqrtf(tot * (1.f / 1024.f) + EPS); }
    const float sc = 0.08838834764831845f * 1.4426950408889634f * rq;
    float sum = 0.f;
    const float inv_dummy = 0.f; (void)inv_dummy;
    float inv = 0.f;
#pragma unroll 1
    for (int dh = 0; dh < 2; ++dh) {
        f32x16 OT[2];
#pragma unroll
        for (int db = 0; db < 2; ++db)
#pragma unroll
            for (int e = 0; e < 16; ++e) OT[db][e] = 0.f;
        float psum = 0.f;
#pragma unroll
        for (int kb = 0; kb < 8; ++kb) {
            float p[16];
#pragma unroll
            for (int e = 0; e < 16; ++e) { p[e] = __builtin_amdgcn_exp2f((X[kb][e] - m) * sc); psum += p[e]; }
#pragma unroll
            for (int s = 0; s < 2; ++s) {
                u32x4 pw; pw.x = pk2(p[8 * s + 0], p[8 * s + 1]); pw.y = pk2(p[8 * s + 2], p[8 * s + 3]); pw.z = pk2(p[8 * s + 4], p[8 * s + 5]); pw.w = pk2(p[8 * s + 6], p[8 * s + 7]);
                bf16x8 pf; __builtin_memcpy(&pf, &pw, 16);
#pragma unroll
                for (int db = 0; db < 2; ++db) { const LAS bf16* vr = VTL + (32 * (2 * dh + db) + r32) * 264 + 32 * kb + 16 * s + 4 * hh;
                    const u32x2 v0 = *(const LAS u32x2*)vr, v1 = *(const LAS u32x2*)(vr + 8);
                    const u32x4 vw = {v0.x, v0.y, v1.x, v1.y}; bf16x8 vf; __builtin_memcpy(&vf, &vw, 16);
                    OT[db] = __builtin_amdgcn_mfma_f32_32x32x16_bf16(vf, pf, OT[db], 0, 0, 0); }
            }
        }
        if (dh == 0) { sum = psum + __shfl_xor(psum, 32); inv = 1.f / sum; }
#pragma unroll
        for (int db = 0; db < 2; ++db)
#pragma unroll
            for (int g4 = 0; g4 < 4; ++g4) { u32x2 w; w.x = pk2(OT[db][4 * g4] * inv, OT[db][4 * g4 + 1] * inv); w.y = pk2(OT[db][4 * g4 + 2] * inv, OT[db][4 * g4 + 3] * inv);
                *(u32x2*)(O + qrow * 512 + h * 128 + 32 * (2 * dh + db) + 8 * g4 + 4 * hh) = w; }
    }
}
__device__ __forceinline__ void xattn_pair(const Args& a, const Ctx& c0, int l, int pair) {
    RELAUNDER_CTX(c0);
    const int qb0 = (pair & 7) * 2, h = (pair >> 3) & 3, b = pair >> 5;
    const bf16* KV = (const bf16*)(c.ws + WS_KV) + (size_t)l * MROWS * 1024;
    LAS bf16* KL = (LAS bf16*)(c.lds + XA_K); LAS bf16* VTL = (LAS bf16*)(c.lds + XA_VT);
    __syncthreads();
#pragma unroll
    for (int i = 0; i < 8; ++i) { const int idx = c.tid + NTHR * i, key = idx >> 4, d0 = (idx & 15) * 8; const bf16* src = KV + (size_t)(b * 256 + key) * 1024 + h * 128 + d0;
        *(LAS u32x4*)(KL + key * 136 + d0) = *(const u32x4*)src;
        const u32x4 v = *(const u32x4*)(src + 512);
        VTL[(d0 + 0) * 264 + key] = (bf16)(v.x & 0xffffu); VTL[(d0 + 1) * 264 + key] = (bf16)(v.x >> 16); VTL[(d0 + 2) * 264 + key] = (bf16)(v.y & 0xffffu); VTL[(d0 + 3) * 264 + key] = (bf16)(v.y >> 16);
        VTL[(d0 + 4) * 264 + key] = (bf16)(v.z & 0xffffu); VTL[(d0 + 5) * 264 + key] = (bf16)(v.z >> 16); VTL[(d0 + 6) * 264 + key] = (bf16)(v.w & 0xffffu); VTL[(d0 + 7) * 264 + key] = (bf16)(v.w >> 16); }
    __syncthreads();
    xattn_compute(c, l, b, h, qb0);
    { RELAUNDER_CTX(c0); (void)c; }
    xattn_compute(c, l, b, h, qb0 + 1);
}

constexpr int PH_PER_LAYER = 16, NPHASE = 2 + PH_PER_LAYER * DEPTH + 0;
#ifndef PHMASK
#define PHMASK 0xFFFFFFFFu
#endif
#define PHEN(k) (((PHMASK) >> (k)) & 1u)
#ifndef REPMASK
#define REPMASK 0u
#endif
#define REPN(k) ((((REPMASK) >> (k)) & 1u) ? 2 : 1)
#ifndef ABL_NOCROSS
#define ABL_NOCROSS 0
#endif
#ifndef ABL_NOMOE
#define ABL_NOMOE 0
#endif
#ifndef N_LAUNCHES
#define N_LAUNCHES 1
#endif

__global__ void __launch_bounds__(NTHR, 2) mega_fwd(Args args) {
    extern __shared__ __attribute__((aligned(16))) unsigned char lds_raw[];
#define MKCTX() do { int _tz; { const unsigned _hw = (unsigned)__builtin_amdgcn_s_getreg((5 << 11) | 4) & 63u; const int _wv = __builtin_amdgcn_readfirstlane((int)((volatile LAS unsigned*)(lds_raw + MISC_OFF + 256))[_hw]); \
        unsigned _on = ~0u; asm volatile("" : "+s"(_on)); _tz = _wv * 64 + (int)__builtin_amdgcn_mbcnt_hi(_on, __builtin_amdgcn_mbcnt_lo(_on, 0u)); } asm volatile("" : "+v"(_tz)); unsigned _lz = 0u; asm volatile("" : "+s"(_lz)); int _bz = blockIdx.x; asm volatile("" : "+s"(_bz)); int _gz = gridDim.x; asm volatile("" : "+s"(_gz)); \
        c.lds = (LAS unsigned char*)lds_raw + _lz; c.z = (int)_lz; c.tid = _tz; c.lane = _tz & 63; c.wave = __builtin_amdgcn_readfirstlane(_tz >> 6); c.G = _gz; \
        c.vcu = (_gz % 8 == 0) ? (_bz % 8) * (_gz / 8) + _bz / 8 : _bz; c.gw = c.vcu * NWAVES + c.wave; c.NGW = _gz * NWAVES; bx = _bz; c.bx = _bz; \
        { size_t _wz = 0; asm volatile("" : "+s"(_wz)); ws = args.ws + _wz; } c.ws = ws; HY = (bf16*)(ws + WS_HY); } while (0)
    Ctx c; int bx; unsigned char* ws; bf16* HY;
    { const int t0 = threadIdx.x; volatile LAS unsigned* M0 = (volatile LAS unsigned*)((LAS unsigned char*)lds_raw + MISC_OFF);
      if (t0 < 64) M0[t0] = 0u;
      if ((t0 & 63) == 0) M0[64 + ((unsigned)__builtin_amdgcn_s_getreg((5 << 11) | 4) & 63u)] = (unsigned)(t0 >> 6);
      __syncthreads(); }
    MKCTX();
    volatile LAS unsigned* MISC = (volatile LAS unsigned*)(c.lds + MISC_OFF);
    unsigned* ctl = (unsigned*)(args.ws + WS_CTL);
    XcdBarrier bar = xcd_barrier_post(ctl + CW_BAR, MISC + 8, c.tid);
    const int lo = args.ph_lo, hi = args.ph_hi;
#define IN(k) (lo <= (k) && (k) < hi)
#define SEAM(k) do { if (IN(k) && IN((k) + 1)) xcd_barrier(bar, c.tid); } while (0)

    if (PHEN(0) && IN(0)) { MKCTX();
        for (int job = c.vcu; job < 256; job += c.G) s5_tables_job(args, c, job);
        __syncthreads();
        for (int it = c.gw; it < 2 * NM_ITEMS; it += c.NGW) conv_weights_nm(args, c, it >= NM_ITEMS ? 1 : 0, it >= NM_ITEMS ? it - NM_ITEMS : it);
        memn_phase(args, c);
        norm_phase<0, false>(args, c, args.in[I_NORM_MIX + c.z]);
#ifdef REP_P0
        __syncthreads();
        for (int job = c.vcu; job < 256; job += c.G) s5_tables_job(args, c, job);
        __syncthreads();
        for (int it = c.gw; it < 2 * NM_ITEMS; it += c.NGW) conv_weights_nm(args, c, it >= NM_ITEMS ? 1 : 0, it >= NM_ITEMS ? it - NM_ITEMS : it);
        memn_phase(args, c);
        norm_phase<0, false>(args, c, args.in[I_NORM_MIX + c.z]);
#endif
    }
    SEAM(0);
#ifdef REP_BARRIERS
    for (int rb_ = 0; rb_ < 32; ++rb_) xcd_barrier(bar, c.tid);
#endif
    for (int l = 0; l < DEPTH; ++l) {
        const int pb = 2 + PH_PER_LAYER * l;
        if (PHEN(2) && IN(pb + 0)) { MKCTX();
            if (l == 0) {
#pragma unroll 1
                for (int lk = 0; lk < DEPTH; ++lk) { const int ck = bx - 128 - 32 * lk;
                    pg8::Sched2D Sk{(const char*)(ws + WS_MEMN), (const char*)(ws + WS_WNM + (size_t)lk * WN_LAYER + WN_CKV), (size_t)256 * 1024 * 2, (size_t)256 * 1024 * 2, MROWS / 256, 4, c.G, (ck >= 0 && ck < 32) ? ck : 1 << 20};
                    pg8::EpiBf16 Ek{(bf16*)(ws + WS_KV) + (size_t)lk * MROWS * 1024, 1024};
                    pg8::gemm_phase(c.lds, c.tid, Sk, Ek, 1024, 1024, 1024); }
            }
        }
        if (PHEN(2) && IN(pb + 0)) { MKCTX();
            pg8::Sched2DSplit S8{(const char*)(ws + WS_H8), (const char*)(ws + WS_WNM + (size_t)l * WN_LAYER + WN_IN + (size_t)NPROJ * 1024 * 2), (size_t)256 * 1024, (size_t)256 * 1024, T / 256, NGATE / 256, c.G, bx, l == 0 ? 8 : 7};
            pg8::EpiGate8 E8{ws + WS_GATES};
            pg8::gemm_phase(c.lds, c.tid, S8, E8, 512, 512, 512);
#ifdef REP_G8
            pg8::gemm_phase(c.lds, c.tid, S8, E8, 512, 512, 512);
#endif
        }
        if (PHEN(2) && IN(pb + 0)) { MKCTX();
            pg8::Sched2D S{(const char*)HY, (const char*)(ws + WS_WNM + (size_t)l * WN_LAYER + WN_IN), (size_t)256 * 1024 * 2, (size_t)256 * 1024 * 2, T / 256, NPROJ / 256, c.G, bx};
            pg8::EpiInProj E{(bf16*)(ws + WS_PROJ), ws + WS_GATES};
            pg8::gemm_phase(c.lds, c.tid, S, E, 1024, 1024, 1024);
        }
        SEAM(pb + 0);
        if (PHEN(3) && IN(pb + 1)) { MKCTX();
            token_prep_phase(args, c, l);
            gla_tasks<1>(args, c, l);
            for (int u = bx; u < 256; u += c.G) s5_1_unit(args, c, l, u);
#ifdef REP_GLA1
            __syncthreads();
            gla_tasks<1>(args, c, l);
#endif
#ifdef REP_S51
            __syncthreads();
            for (int u = bx; u < 256; u += c.G) s5_1_unit(args, c, l, u);
#endif
        }
        SEAM(pb + 1);
        if (PHEN(4) && IN(pb + 2)) { MKCTX();
            gla2_phase(args, c);
            s5_2_phase(args, c, l);
#ifdef REP_DSA_NOATT
            dsa_phase<0>(args, c, l);
#endif
#ifdef REP_DSA_NOSC
            dsa_phase<3>(args, c, l);
#endif
#ifdef REP_DSA_FIXK
            dsa_phase<2>(args, c, l);
#endif
#ifdef REP_DSA
            dsa_phase<1>(args, c, l);
#endif
            dsa_phase<1>(args, c, l);
        }
        SEAM(pb + 2);
        if (PHEN(5) && IN(pb + 3)) { MKCTX();
            gla_tasks<3>(args, c, l);
            for (int u = bx; u < 256; u += c.G) s5_3_unit(args, c, l, u);
#ifdef REP_GLA3
            __syncthreads();
            gla_tasks<3>(args, c, l);
#endif
#ifdef REP_S53
            __syncthreads();
            for (int u = bx; u < 256; u += c.G) s5_3_unit(args, c, l, u);
#endif
        }
        SEAM(pb + 3);
        if (PHEN(6) && IN(pb + 4)) { MKCTX();
            pg8::Sched2D S{(const char*)(ws + WS_YPRE), (const char*)(ws + WS_WNM + (size_t)l * WN_LAYER + WN_GLU), (size_t)256 * 256 * 2, (size_t)256 * 256 * 2, T / 256, 1, c.G, bx};
            pg8::EpiGlu E{(const bf16*)(ws + WS_YPRE), args.in[I_S5_BGLU + c.z] + (size_t)l * 256, HY};
            pg8::gemm_phase(c.lds, c.tid, S, E, 256, 256, 256);
            if (REPN(6) == 2) { pg8::gemm_phase(c.lds, c.tid, S, E, 256, 256, 256); }
        }
        SEAM(pb + 4);
        if (PHEN(7) && IN(pb + 5)) { MKCTX();
            pg8::SchedBranch S{(const char*)HY, (const char*)(ws + WS_WNM + (size_t)l * WN_LAYER + WN_BR), T / 256, 4, c.G, bx};
            pg8::EpiBranch E{ws + WS_GATES, (bf16*)(ws + WS_MERGED)};
            pg8::gemm_phase(c.lds, c.tid, S, E, 256, 1024, 1024);
            if (REPN(7) == 2) { pg8::gemm_phase(c.lds, c.tid, S, E, 256, 1024, 1024); }
        }
        SEAM(pb + 5);
        if (PHEN(8) && IN(pb + 6)) { MKCTX();
            pg8::Sched2D S{(const char*)(ws + WS_MERGED), (const char*)(ws + WS_WNM + (size_t)l * WN_LAYER + WN_OUT), (size_t)256 * 1024 * 2, (size_t)256 * 1024 * 2, T / 256, 4, c.G, bx};
            pg8::EpiResidX E{args.out, HY, (float*)(ws + WS_SSQ), l == 0 ? args.in[I_X + c.z] : (const float*)args.out};
            pg8::gemm_phase(c.lds, c.tid, S, E, 1024, 1024, 1024);
        }
        SEAM(pb + 6);
        if (PHEN(10) && IN(pb + 8)) { MKCTX();
            pg8::Sched2D S{(const char*)HY, (const char*)(ws + WS_WNM + (size_t)l * WN_LAYER + WN_CQ), (size_t)256 * 1024 * 2, (size_t)256 * 1024 * 2, T / 256, 2, c.G, bx};
            pg8::EpiBf16 E{(bf16*)(ws + WS_Q), 512};
            pg8::gemm_phase(c.lds, c.tid, S, E, 1024, 1024, 1024);
            if (REPN(10) == 2) { pg8::gemm_phase(c.lds, c.tid, S, E, 1024, 1024, 1024); }
        }
        SEAM(pb + 8);
        if (PHEN(11) && IN(pb + 9)) { MKCTX(); for (int u = bx; u < 256; u += c.G) xattn_pair(args, c, l, u);
#ifdef REP_XATTN
            for (int u = bx; u < 256; u += c.G) xattn_pair(args, c, l, u);
#endif
        }
        SEAM(pb + 9);
        if (PHEN(12) && IN(pb + 10) && !ABL_NOCROSS) { MKCTX();
            pg8::Sched2D S{(const char*)(ws + WS_O), (const char*)(ws + WS_WNM + (size_t)l * WN_LAYER + WN_CO), (size_t)256 * 512 * 2, (size_t)256 * 512 * 2, T / 256, 4, c.G, bx};
            pg8::EpiResid E{args.out};
            pg8::gemm_phase(c.lds, c.tid, S, E, 512, 512, 512);
        }
        SEAM(pb + 10);
        if (PHEN(13) && IN(pb + 11)) { MKCTX();
            ffn_norm_route_phase(args, c, l);
            __syncthreads();
            for (int it = c.gw; it < MOE_ITEMS; it += c.NGW) conv_weights_moe(args, c, l, it);
        }
        SEAM(pb + 11);
        if (PHEN(15) && IN(pb + 13)) { MKCTX();
            LAS int* tb = (LAS int*)(c.lds + 140000); moe_tables(c, l, tb);
            pg8::SchedMoe<true> S{(const char*)(ws + WS_H8F), (const char*)(ws + WS_WMOE + WM_GU), (size_t)0, (size_t)1024 * 1024, (size_t)256 * 1024, tb, (const int*)(ws + WS_ROWMAP), 4, c.G, bx};
            pg8::EpiGateUp8 E{ws + WS_HE};
            pg8::gemm_phase(c.lds, c.tid, S, E, 512, 512, 512);
        }
        SEAM(pb + 13);
        if (PHEN(16) && IN(pb + 14)) { MKCTX();
            LAS int* tb = (LAS int*)(c.lds + 140000); moe_tables(c, l, tb);
            pg8::SchedMoe<false> S{(const char*)(ws + WS_HE), (const char*)(ws + WS_WMOE + WM_DN), (size_t)256 * 512, (size_t)1024 * 512, (size_t)256 * 512, tb, (const int*)(ws + WS_ROWMAP), 4, c.G, bx};
            pg8::EpiBf16S8 E{(bf16*)(ws + WS_OB), 1024, 1.f / 512.f};
            pg8::gemm_phase(c.lds, c.tid, S, E, 256, 256, 256);
        }
        SEAM(pb + 14);
        if (PHEN(17) && IN(pb + 15)) { MKCTX();
            if (l + 1 < DEPTH) norm_phase<ABL_NOMOE ? 1 : 2, false>(args, c, args.in[I_NORM_MIX + c.z] + (size_t)(l + 1) * 1024, l);
            else norm_phase<ABL_NOMOE ? 1 : 2, true>(args, c, args.in[I_NORM_FINAL + c.z], l);
        }
        SEAM(pb + 15);
    }
#undef IN
#undef SEAM
}

extern "C" void kernel_launch(void* const* d_in, const int* in_sizes, int n_in, void* d_out, int out_size, void* d_ws, size_t ws_size, hipStream_t stream) {
    static int grid = 0;
    if (grid == 0) {
        if (n_in != 36 || out_size != T * D || ws_size < WS_END) { fprintf(stderr, "kernel_launch: unexpected shapes: n_in %d out %d ws %zu (need %zu)\n", n_in, out_size, ws_size, (size_t)WS_END); grid = -1; return; }
        int dev = 0, cus = 0, per_cu = 0;
        if (hipGetDevice(&dev) != hipSuccess || hipDeviceGetAttribute(&cus, hipDeviceAttributeMultiprocessorCount, dev) != hipSuccess) { grid = -1; return; }
        if (hipFuncSetAttribute((const void*)mega_fwd, hipFuncAttributeMaxDynamicSharedMemorySize, LDS_BYTES) != hipSuccess) { fprintf(stderr, "kernel_launch: hipFuncSetAttribute failed\n"); grid = -1; return; }
        if (hipOccupancyMaxActiveBlocksPerMultiprocessor(&per_cu, (const void*)mega_fwd, NTHR, LDS_BYTES) != hipSuccess || per_cu < 1) fprintf(stderr, "kernel_launch: occupancy query reports %d\n", per_cu);
        (void)hipGetLastError();
        grid = cus;
        if (grid != 256) fprintf(stderr, "kernel_launch: %d CUs (built for 256)\n", grid);
    }
    if (grid < 0) return;
    if (hipMemsetAsync((char*)d_ws + WS_CTL, 0, CTL_ZERO_BYTES, stream) != hipSuccess) return;
    Args a{};
    for (int i = 0; i < 36; ++i) a.in[i] = (const float*)d_in[i];
    a.out = (float*)d_out; a.ws = (unsigned char*)d_ws;
#if N_LAUNCHES == 1
    a.ph_lo = 0; a.ph_hi = NPHASE;
    hipLaunchKernelGGL(mega_fwd, dim3(grid), dim3(NTHR), LDS_BYTES, stream, a);
#else
    for (int p = 0; p < NPHASE; ++p) { a.ph_lo = p; a.ph_hi = p + 1; hipLaunchKernelGGL(mega_fwd, dim3(grid), dim3(NTHR), LDS_BYTES, stream, a); }
#endif
}
```

```cpp
#include <hip/hip_runtime.h>
#include <cstdio>
#include <cstdint>

#define GAS __attribute__((address_space(1)))
#define LAS __attribute__((address_space(3)))
typedef unsigned short bf16;
typedef short bf16x8 __attribute__((ext_vector_type(8)));
typedef float f32x4 __attribute__((ext_vector_type(4)));
typedef float f32x16 __attribute__((ext_vector_type(16)));
typedef float f32x2 __attribute__((ext_vector_type(2)));
typedef unsigned u32x4 __attribute__((ext_vector_type(4)));
typedef unsigned u32x2 __attribute__((ext_vector_type(2)));

constexpr int NWAVES = 8, NTHR = 512;
constexpr int BATCH = 8, SEQ = 4096, T = BATCH * SEQ, D = 1024, DEPTH = 2, MEMLEN = 256, MROWS = BATCH * MEMLEN;
constexpr int D_IN = 6840, NPROJ = 2816, NGATE = 4096, NIN = NPROJ + NGATE;
constexpr int C_CH = 0, C_CB = 256, C_CC = 512, C_GQ = 768, C_GK = 1024, C_GV = 1280, C_GR = 1536, C_SU = 1792, C_DQ = 2048, C_IQ = 2304,
              C_DK = 2560, C_DV = 2624, C_IK = 2688, C_IW = 2720, C_GA = 2736, C_IL = 2752;
#define POFF(t, col) (((size_t)((col) >> 8) * T + (size_t)(t)) * 256 + ((col) & 255))
constexpr int NEXP = 16, DFF = 512;
constexpr int MOE_ROWS = 2 * T + NEXP * 256;
constexpr float EPS = 1e-6f;

constexpr size_t MiB = 1u << 20;
constexpr size_t WS_CTL = 0, CTL_ZERO_BYTES = 1 * MiB;
constexpr size_t WS_TOKPOS = 1 * MiB;
constexpr size_t WS_TOKW = WS_TOKPOS + 256 * 1024;
constexpr size_t WS_TILEE = WS_TOKW + 256 * 1024;
constexpr size_t WS_LAML = WS_TILEE + 4096;
constexpr size_t WS_GDEC = 2 * MiB;
constexpr size_t WS_MEMN = 3 * MiB;
constexpr size_t WS_K8 = WS_MEMN;
constexpr size_t WS_V8 = WS_MEMN + 2 * MiB;
constexpr size_t WS_ROWMAP = WS_MEMN; constexpr int CAPE = 32768;
constexpr size_t WS_KV = 7 * MiB;
constexpr size_t WS_WNM = 15 * MiB;
constexpr size_t WN_IN = 0, WN_BR = WN_IN + (size_t)NIN * 1024 * 2, WN_OUT = WN_BR + 2 * MiB, WN_CQ = WN_OUT + 2 * MiB, WN_CKV = WN_CQ + 1 * MiB,
                 WN_CO = WN_CKV + 2 * MiB, WN_GLU = WN_CO + 1 * MiB, WN_S5E = WN_GLU + 128 * 1024, WN_S5B = WN_S5E + 1 * MiB, WN_LAYER = WN_S5B + 3 * MiB;
static_assert(WN_LAYER == 26869760, "weights per layer");
constexpr size_t WS_WMOE = 67 * MiB;
constexpr size_t WM_GU = 0, WM_DN = 32 * MiB;
constexpr size_t WS_GSLOC = WS_WMOE, WS_XE = WS_WMOE + 32 * MiB;
constexpr size_t WS_H8 = WS_WMOE;
constexpr size_t WS_HY = 115 * MiB;
constexpr size_t WS_GATES = 179 * MiB;
constexpr size_t WS_HE = WS_GATES;
constexpr size_t WS_H8F = WS_GATES + 96 * MiB;
constexpr size_t WS_PROJ = 307 * MiB;
constexpr size_t WS_MERGED = WS_PROJ, WS_Q = WS_PROJ, WS_O = WS_PROJ + 32 * MiB, WS_HS = WS_PROJ, WS_OB = WS_PROJ;
constexpr size_t WS_XP = 483 * MiB;
constexpr size_t WS_SSQ = WS_XP;
constexpr size_t WS_YPRE = 491 * MiB;
constexpr size_t WS_END = 512 * MiB;
static_assert(WS_WNM + 2 * WN_LAYER <= WS_WMOE && WS_PROJ + (size_t)T * NPROJ * 2 <= WS_XP && WS_YPRE + (size_t)T * 256 * 2 <= WS_END && (size_t)MOE_ROWS * 1024 * 2 <= 176 * MiB && (size_t)MOE_ROWS * 512 * 2 <= 128 * MiB, "ws map");
constexpr int CW_BAR = 4096;
constexpr int CW_DSAQ = 16384;
constexpr int CW_MOECNT = 8192;

constexpr int LDS_BYTES = 155648;
constexpr int MISC_OFF = LDS_BYTES - 512;

__device__ __forceinline__ float bf2f(unsigned b) { return __uint_as_float(b << 16); }
__device__ __forceinline__ void lds_barrier() { asm volatile("s_waitcnt lgkmcnt(0)" ::: "memory"); __builtin_amdgcn_s_barrier(); asm volatile("" ::: "memory"); }
__device__ __forceinline__ float bflo(unsigned w) { return __uint_as_float(w << 16); }
__device__ __forceinline__ float bfhi(unsigned w) { return __uint_as_float(w & 0xffff0000u); }
__device__ __forceinline__ unsigned f2bf(float f) { unsigned u = __float_as_uint(f); return (u + 0x7fffu + ((u >> 16) & 1u)) >> 16; }
__device__ __forceinline__ unsigned pk2(float lo, float hi) { return f2bf(lo) | (f2bf(hi) << 16); }
__device__ __forceinline__ float wave_sum(float v) {
#pragma unroll
    for (int o = 1; o < 64; o <<= 1) v += __shfl_xor(v, o);
    return v;
}
__device__ __forceinline__ float wave_max(float v) {
#pragma unroll
    for (int o = 1; o < 64; o <<= 1) v = fmaxf(v, __shfl_xor(v, o));
    return v;
}
__device__ __forceinline__ float sigmoidf_(float x) { return __builtin_amdgcn_rcpf(1.f + __expf(-x)); }

#define XB_TMO      128
#define XB_XCNT(j)  (256  + 64 * (j))
#define XB_XSUB(j)  (1280 + 64 * (j))
#define XB_XGEN(j)  (2304 + 64 * (j))
#define XB_TOP      3328
#define XB_TOPGEN   3392
#define XCD_BAR_WORDS 3456
#define XB_SPIN_CAP (1u << 18)
__device__ __forceinline__ unsigned xb_ld(unsigned* p)              { return __hip_atomic_load(p, __ATOMIC_RELAXED, __HIP_MEMORY_SCOPE_AGENT); }
__device__ __forceinline__ unsigned xb_add(unsigned* p, unsigned v) { return __hip_atomic_fetch_add(p, v, __ATOMIC_RELAXED, __HIP_MEMORY_SCOPE_AGENT); }
__device__ __forceinline__ unsigned xb_xcc_id() { return (unsigned)__builtin_amdgcn_s_getreg((3 << 11) | 20) & 0xFu; }
#define XB_SPIN(cond, bar) do { unsigned _sp = 0; while (cond) { __builtin_amdgcn_s_sleep(1); \
    if ((++_sp & 255u) == 0u) { if (xb_ld(&(bar)[XB_TMO])) break; if (_sp > XB_SPIN_CAP) { atomicAdd(&(bar)[XB_TMO], 1u); break; } } } } while (0)
struct XcdBarrier { unsigned* bar; unsigned x; volatile LAS unsigned* st; };
__device__ __forceinline__ XcdBarrier xcd_barrier_post(unsigned* bar, volatile LAS unsigned* st, int tid) {
    XcdBarrier b; b.bar = bar; b.x = xb_xcc_id(); b.st = st;
    if (tid == 0) (void)xb_add(&bar[XB_XCNT(b.x)], 1u);
    return b;
}
__device__ __forceinline__ unsigned xcd_barrier_complete(unsigned* bar, unsigned x) {
    const unsigned G = gridDim.x * gridDim.y * gridDim.z;
    unsigned sum, cnt, mine, sp = 0u;
    for (;;) {
        sum = 0u; cnt = 0u;
#pragma unroll 1
        for (unsigned j = 0; j < 16; ++j) { const unsigned c = xb_ld(&bar[XB_XCNT(j)]); sum += c; cnt += (c > 0u) ? 1u : 0u; }
        mine = xb_ld(&bar[XB_XCNT(x)]);
        if (sum == G) break;
        __builtin_amdgcn_s_sleep(1);
        if ((++sp & 255u) == 0u) { if (xb_ld(&bar[XB_TMO])) break; if (sp > XB_SPIN_CAP) { atomicAdd(&bar[XB_TMO], 1u); break; } }
    }
    const unsigned nloc = mine > 0u ? mine : 1u, nx = cnt > 0u ? cnt : 1u;
    return nloc | (nx << 16);
}
__device__ __forceinline__ void xcd_barrier(const XcdBarrier& b, int tid) {
    asm volatile("s_waitcnt vmcnt(0)" ::: "memory");
    __syncthreads();
    if (tid == 0) {
        unsigned* bar = b.bar;
        __builtin_amdgcn_s_waitcnt(0);
        unsigned nloc = b.st[0], nx = b.st[1];
        if (nloc == 0u) { const unsigned r = xcd_barrier_complete(bar, b.x); nloc = r & 0xffffu; nx = r >> 16; b.st[0] = nloc; b.st[1] = nx; }
        const unsigned old = xb_add(&bar[XB_XSUB(b.x)], 1u);
        const unsigned gen = old / nloc;
        if (old + 1u == (gen + 1u) * nloc) {
            __builtin_amdgcn_fence(__ATOMIC_RELEASE, "agent");
            asm volatile("s_waitcnt vmcnt(0)" ::: "memory");
            const unsigned og = xb_add(&bar[XB_TOP], 1u);
            const unsigned tg = og / nx;
            if (og + 1u == (tg + 1u) * nx) xb_add(&bar[XB_TOPGEN], 1u);
            else XB_SPIN(xb_ld(&bar[XB_TOPGEN]) == tg, bar);
            __builtin_amdgcn_fence(__ATOMIC_ACQUIRE, "agent");
            xb_add(&bar[XB_XGEN(b.x)], 1u);
            asm volatile("s_waitcnt vmcnt(0)" ::: "memory");
        } else {
            XB_SPIN(xb_ld(&bar[XB_XGEN(b.x)]) == gen, bar);
            __builtin_amdgcn_fence(__ATOMIC_ACQUIRE, "agent");
            asm volatile("s_waitcnt vmcnt(0)" ::: "memory");
        }
    }
    __syncthreads();
}

#ifndef GEMM_ALIGN
#define GEMM_ALIGN 1
#endif
namespace pg8 {
constexpr int BM = 256, BK = 64, HALF = 128, HTB = HALF * BK * 2, STAGE_BYTES = 8 * HTB, NXCD = 8, WGM = 8;
__host__ __device__ __forceinline__ int lds_byte(int r, int c) { const int st = (r >> 4) * 2 + (c >> 5), rr = r & 15, cc = c & 31, ob = rr * 64 + cc * 2; return st * 1024 + (ob ^ (((ob >> 9) & 1) << 5)); }
__host__ __device__ __forceinline__ void stage_rc(int b, int& R, int& C) { const int st = b / 1024, sb = b % 1024, swz = sb ^ (((sb >> 9) & 1) << 5); R = (st >> 1) * 16 + swz / 64; C = (st & 1) * 32 + (swz % 64) / 2; }
__host__ __device__ __forceinline__ int perm32(int rho) { const int n = rho >> 4, i = rho & 15; return 8 * (i >> 2) + 4 * n + (i & 3); }

struct Unit { const char* A; const char* B; int pm, pn, aux; const int* amap; int avalid; };

__device__ __forceinline__ void tile_of(int L, int nM, int nN, int& pm, int& pn) {
    const int nwg = nM * nN; int wgid = L;
    { const int q = nwg / NXCD, r = nwg % NXCD, xcd = wgid % NXCD, off = wgid / NXCD; wgid = (xcd < r ? xcd * (q + 1) : r * (q + 1) + (xcd - r) * q) + off; }
    const int nig = WGM * nN, gid = wgid / nig, fm = gid * WGM, gsz = (nM - fm) < WGM ? (nM - fm) : WGM;
    pm = fm + ((wgid % nig) % gsz); pn = (wgid % nig) / gsz;
}
struct Sched2D {
    static constexpr bool GATHER = false;
    const char* A; const char* B; size_t atile, btile; int nM, nN, G, c;
    __device__ __forceinline__ bool next(int i, Unit& u) const {
        const long L = (long)i * G + c; if (L >= (long)nM * nN) return false;
        int pm, pn; tile_of((int)L, nM, nN, pm, pn);
        u.A = A + (size_t)pm * atile; u.B = B + (size_t)pn * btile; u.pm = pm; u.pn = pn; u.aux = 0; u.amap = nullptr; u.avalid = 0; return true;
    }
};
struct Sched2DSplit {
    static constexpr bool GATHER = false;
    const char* A; const char* B; size_t atile, btile; int nM, nN, G, c, nlo;
    __device__ __forceinline__ bool next(int i, Unit& u) const {
        const int half = G >> 1; long L;
        if (c < half) { if (i >= nlo) return false; L = (long)i * half + c; } else L = (long)nlo * half + (long)i * (G - half) + (c - half);
        if (L >= (long)nM * nN) return false;
        int pm, pn; tile_of((int)L, nM, nN, pm, pn);
        u.A = A + (size_t)pm * atile; u.B = B + (size_t)pn * btile; u.pm = pm; u.pn = pn; u.aux = 0; u.amap = nullptr; u.avalid = 0; return true;
    }
};
struct SchedBranch {
    static constexpr bool GATHER = false;
    const char* A; const char* B; int nM, nN, G, c;
    __device__ __forceinline__ bool next(int i, Unit& u) const {
        const long L = (long)(i >> 2) * G + c; if (L >= (long)nM * nN) return false;
        int pm, pn; tile_of((int)L, nM, nN, pm, pn); const int sub = i & 3;
        u.A = A + (size_t)pm * (256 * 1024 * 2) + sub * 512; u.B = B + (size_t)pn * (256 * 1024 * 2) + sub * 512; u.pm = pm; u.pn = pn; u.aux = sub; u.amap = nullptr; u.avalid = 0; return true;
    }
};
template <bool GATHER_>
struct SchedMoe {
    static constexpr bool GATHER = GATHER_;
    const char* A; const char* B; size_t atile, bexp, btile; LAS const int* tb; const int* rowmap; int nN, G, c;
    __device__ __forceinline__ bool next(int i, Unit& u) const {
        const long L = (long)i * G + c; if (L >= (long)__builtin_amdgcn_readfirstlane(tb[16]) * nN) return false;
        const int pm = (int)(L / nN), pn = (int)(L % nN);
        int e = 0, t0 = 0;
#pragma unroll
        for (int q = 1; q < 16; ++q) { const int tq = __builtin_amdgcn_readfirstlane(tb[q]); if (pm >= tq) { e = q; t0 = tq; } }
        const int ti = pm - t0;
        u.A = GATHER_ ? A : A + (size_t)pm * atile; u.B = B + (size_t)e * bexp + (size_t)pn * btile; u.pm = pm; u.pn = pn; u.aux = e;
        u.amap = rowmap + (size_t)e * CAPE + ti * 256; const int left = __builtin_amdgcn_readfirstlane(tb[17 + e]) - ti * 256; u.avalid = left < 256 ? left : 256; return true;
    }
};

__device__ __forceinline__ unsigned cvt_pk_bf16(float lo, float hi) { unsigned r; asm volatile("v_cvt_pk_bf16_f32 %0, %1, %2" : "=v"(r) : "v"(lo), "v"(hi)); return r; }

typedef f32x4 Acc[2][2][4][2];
typedef int i32x4_ __attribute__((ext_vector_type(4))); typedef int i32x8_ __attribute__((ext_vector_type(8)));

struct EpiBf16 {
    static constexpr bool PERM = true;
    bf16* O; int ldc;
    __device__ __forceinline__ bool operator()(Acc& acc, const Unit& u, int wr, int wc, int fr, int fq) const {
        const int row0 = u.pm * BM + wr * 64 + fr, col0 = u.pn * BM + wc * 32 + 8 * fq;
#pragma unroll
        for (int ai = 0; ai < 2; ++ai)
#pragma unroll
            for (int m = 0; m < 4; ++m) { bf16* rowp = O + (size_t)(row0 + ai * HALF + m * 16) * ldc + col0;
#pragma unroll
                for (int bj = 0; bj < 2; ++bj) { const f32x4 v0 = acc[ai][bj][m][0], v1 = acc[ai][bj][m][1];
                    u32x4 w; w.x = cvt_pk_bf16(v0[0], v0[1]); w.y = cvt_pk_bf16(v0[2], v0[3]); w.z = cvt_pk_bf16(v1[0], v1[1]); w.w = cvt_pk_bf16(v1[2], v1[3]);
                    *(u32x4*)(rowp + bj * HALF) = w; } }
        return false;
    }
};
__device__ __forceinline__ unsigned q8x4(f32x4 v) {
    unsigned w = 0u;
#pragma unroll
    for (int j = 0; j < 4; ++j) { const float s = fmaxf(sigmoidf_(v[j]) * 255.f, 1.f); w = __builtin_amdgcn_cvt_pk_u8_f32(s, j, w); }
    return w;
}
struct EpiInProj {
    static constexpr bool PERM = true;
    bf16* P; unsigned char* Gt;
    __device__ __forceinline__ bool operator()(Acc& acc, const Unit& u, int wr, int wc, int fr, int fq) const {
        const int row0 = u.pm * BM + wr * 64 + fr;
        if (u.pn < 11) {
            const int col0 = wc * 32 + 8 * fq;
#pragma unroll
            for (int ai = 0; ai < 2; ++ai)
#pragma unroll
                for (int m = 0; m < 4; ++m) { bf16* rowp = P + ((size_t)u.pn * T + (size_t)(row0 + ai * HALF + m * 16)) * 256 + col0;
#pragma unroll
                    for (int bj = 0; bj < 2; ++bj) { const f32x4 v0 = acc[ai][bj][m][0], v1 = acc[ai][bj][m][1];
                        u32x4 w; w.x = cvt_pk_bf16(v0[0], v0[1]); w.y = cvt_pk_bf16(v0[2], v0[3]); w.z = cvt_pk_bf16(v1[0], v1[1]); w.w = cvt_pk_bf16(v1[2], v1[3]);
                        *(u32x4*)(rowp + bj * HALF) = w; } }
        } else {
            const int col0 = (u.pn - 11) * BM + wc * 32 + 8 * fq;
#pragma unroll
            for (int ai = 0; ai < 2; ++ai)
#pragma unroll
                for (int m = 0; m < 4; ++m) { unsigned char* rowp = Gt + (size_t)(row0 + ai * HALF + m * 16) * NGATE + col0;
#pragma unroll
                    for (int bj = 0; bj < 2; ++bj) { const f32x4 v0 = acc[ai][bj][m][0], v1 = acc[ai][bj][m][1];
                        u32x2 w; w.x = q8x4(v0); w.y = q8x4(v1);
                        *(u32x2*)(rowp + bj * HALF) = w; } }
        }
        return false;
    }
};
template <class E, class = void> struct EpiFp8 { static constexpr bool v = false; };
template <class E> struct EpiFp8<E, decltype((void)E::FP8)> { static constexpr bool v = E::FP8; };
__device__ __forceinline__ unsigned q8x4s(f32x4 a) {
    unsigned w = 0u;
#pragma unroll
    for (int j = 0; j < 4; ++j) { const float e = __builtin_amdgcn_exp2f(a[j] * (-1.4426950408889634f / 32.f));
        const float s = fmaxf(__builtin_amdgcn_rcpf(__builtin_fmaf(e, 1.f / 255.f, 1.f / 255.f)), 1.f); w = __builtin_amdgcn_cvt_pk_u8_f32(s, j, w); }
    return w;
}
struct EpiGate8 {
    static constexpr bool PERM = true; static constexpr bool FP8 = true;
    unsigned char* Gt;
    __device__ __forceinline__ bool operator()(Acc& acc, const Unit& u, int wr, int wc, int fr, int fq) const {
        const int row0 = u.pm * BM + wr * 64 + fr, col0 = u.pn * BM + wc * 32 + 8 * fq;
#pragma unroll
        for (int ai = 0; ai < 2; ++ai)
#pragma unroll
            for (int m = 0; m < 4; ++m) { unsigned char* rowp = Gt + (size_t)(row0 + ai * HALF + m * 16) * NGATE + col0;
#pragma unroll
                for (int bj = 0; bj < 2; ++bj) { u32x2 w; w.x = q8x4s(acc[ai][bj][m][0]); w.y = q8x4s(acc[ai][bj][m][1]);
                    *(u32x2*)(rowp + bj * HALF) = w; } }
        return false;
    }
};
struct EpiBranch {
    static constexpr bool PERM = true;
    const unsigned char* Gt; bf16* O;
    __device__ __forceinline__ bool operator()(Acc& acc, const Unit& u, int wr, int wc, int fr, int fq) const {
        const int row0 = u.pm * BM + wr * 64 + fr, col0 = u.pn * BM + wc * 32 + 8 * fq, sub = u.aux;
        const bool last = sub == 3;
        const int goff1 = last ? 0 : 1024;
        u32x2 G0[2][4][2], G1[2][4][2];
#pragma unroll
        for (int ai = 0; ai < 2; ++ai)
#pragma unroll
            for (int m = 0; m < 4; ++m) { const size_t row = (size_t)(row0 + ai * HALF + m * 16); const unsigned char* gp = Gt + row * NGATE + sub * 1024 + col0;
#pragma unroll
                for (int bj = 0; bj < 2; ++bj) { G0[ai][m][bj] = *(const u32x2*)(gp + bj * HALF); G1[ai][m][bj] = *(const u32x2*)(gp + goff1 + bj * HALF); } }
        __builtin_amdgcn_sched_barrier(0);
        const float sc = last ? 1.f / 255.f : 1.f;
#pragma unroll
        for (int ai = 0; ai < 2; ++ai)
#pragma unroll
            for (int m = 0; m < 4; ++m) { const size_t row = (size_t)(row0 + ai * HALF + m * 16);
#pragma unroll
                for (int bj = 0; bj < 2; ++bj) {
                    const u32x2 g0 = G0[ai][m][bj];
                    u32x2 g1 = G1[ai][m][bj]; if (last) g1 = (u32x2){0x01010101u, 0x01010101u};
                    f32x4 v0 = acc[ai][bj][m][0], v1 = acc[ai][bj][m][1];
#pragma unroll
                    for (int j = 0; j < 4; ++j) {
                        const float a0 = (float)((g0.x >> (8 * j)) & 255u), b0 = (float)((g1.x >> (8 * j)) & 255u);
                        const float a1 = (float)((g0.y >> (8 * j)) & 255u), b1 = (float)((g1.y >> (8 * j)) & 255u);
                        v0[j] *= a0 * sc * __builtin_amdgcn_rcpf(b0); v1[j] *= a1 * sc * __builtin_amdgcn_rcpf(b1);
                    }
                    acc[ai][bj][m][0] = v0; acc[ai][bj][m][1] = v1;
                    if (last) { u32x4 w; w.x = cvt_pk_bf16(v0[0], v0[1]); w.y = cvt_pk_bf16(v0[2], v0[3]); w.z = cvt_pk_bf16(v1[0], v1[1]); w.w = cvt_pk_bf16(v1[2], v1[3]);
                        *(u32x4*)(O + row * 1024 + col0 + bj * HALF) = w; }
                } }
        return sub < 3;
    }
};
struct EpiResid {
    static constexpr bool PERM = false;
    float* X;
    __device__ __forceinline__ bool operator()(Acc& acc, const Unit& u, int wr, int wc, int fr, int fq) const {
        const int row0 = u.pm * BM + wr * 64 + fr, col0 = u.pn * BM + wc * 32 + 4 * fq;
#pragma unroll
        for (int ai = 0; ai < 2; ++ai)
        {
            f32x4 xv[4][2][2];
#pragma unroll
            for (int m = 0; m < 4; ++m) { const float* rowp = X + (size_t)(row0 + ai * HALF + m * 16) * 1024 + col0;
#pragma unroll
                for (int bj = 0; bj < 2; ++bj)
#pragma unroll
                    for (int n = 0; n < 2; ++n) xv[m][bj][n] = *(const f32x4*)(rowp + bj * HALF + n * 16); }
            __builtin_amdgcn_sched_barrier(0);
#pragma unroll
            for (int m = 0; m < 4; ++m) { float* rowp = X + (size_t)(row0 + ai * HALF + m * 16) * 1024 + col0;
#pragma unroll
                for (int bj = 0; bj < 2; ++bj)
#pragma unroll
                    for (int n = 0; n < 2; ++n) *(f32x4*)(rowp + bj * HALF + n * 16) = xv[m][bj][n] + acc[ai][bj][m][n]; }
            __builtin_amdgcn_sched_barrier(0);
        }
        return false;
    }
};
struct EpiResidX {
    static constexpr bool PERM = false;
    float* X; bf16* XB; float* SSQ; const float* XI;
    __device__ __forceinline__ bool operator()(Acc& acc, const Unit& u, int wr, int wc, int fr, int fq) const {
        const int row0 = u.pm * BM + wr * 64 + fr, col0 = u.pn * BM + wc * 32 + 4 * fq;
#pragma unroll
        for (int ai = 0; ai < 2; ++ai)
        {
            f32x4 xv[4][2][2];
#pragma unroll
            for (int m = 0; m < 4; ++m) { const float* rowi = XI + (size_t)(row0 + ai * HALF + m * 16) * 1024 + col0;
#pragma unroll
                for (int bj = 0; bj < 2; ++bj)
#pragma unroll
                    for (int n = 0; n < 2; ++n) xv[m][bj][n] = *(const f32x4*)(rowi + bj * HALF + n * 16); }
            __builtin_amdgcn_sched_barrier(0);
#pragma unroll
            for (int m = 0; m < 4; ++m) { const size_t row = (size_t)(row0 + ai * HALF + m * 16); float* rowp = X + row * 1024 + col0; bf16* rowb = XB + row * 1024 + col0;
                float ss = 0.f;
#pragma unroll
                for (int bj = 0; bj < 2; ++bj)
#pragma unroll
                    for (int n = 0; n < 2; ++n) { f32x4* p = (f32x4*)(rowp + bj * HALF + n * 16); const f32x4 v = xv[m][bj][n] + acc[ai][bj][m][n]; *p = v;
                        u32x2 w; w.x = cvt_pk_bf16(v[0], v[1]); w.y = cvt_pk_bf16(v[2], v[3]); *(u32x2*)(rowb + bj * HALF + n * 16) = w;
                        ss += (v[0] * v[0] + v[1] * v[1]) + (v[2] * v[2] + v[3] * v[3]); }
                ss += __shfl_xor(ss, 16); ss += __shfl_xor(ss, 32);
                if (fq == 0) SSQ[row * 16 + u.pn * 4 + wc] = ss; }
            __builtin_amdgcn_sched_barrier(0);
        }
        return false;
    }
};
struct EpiGlu {
    static constexpr bool PERM = true;
    const bf16* YP; const float* bias; bf16* O;
    __device__ __forceinline__ bool operator()(Acc& acc, const Unit& u, int wr, int wc, int fr, int fq) const {
        const int row0 = u.pm * BM + wr * 64 + fr, col0 = wc * 32 + 8 * fq;
        f32x4 bv[2][2];
#pragma unroll
        for (int bj = 0; bj < 2; ++bj) { const int c = col0 + bj * HALF; bv[bj][0] = *(const f32x4*)(bias + c); bv[bj][1] = *(const f32x4*)(bias + c + 4); }
#pragma unroll
        for (int ai = 0; ai < 2; ++ai) {
            u32x4 ypv[4][2];
#pragma unroll
            for (int m = 0; m < 4; ++m) { const size_t row = (size_t)(row0 + ai * HALF + m * 16);
#pragma unroll
                for (int bj = 0; bj < 2; ++bj) ypv[m][bj] = *(const u32x4*)(YP + row * 256 + col0 + bj * HALF); }
            __builtin_amdgcn_sched_barrier(0);
#pragma unroll
            for (int m = 0; m < 4; ++m) { const size_t row = (size_t)(row0 + ai * HALF + m * 16);
#pragma unroll
                for (int bj = 0; bj < 2; ++bj) { const int c = col0 + bj * HALF;
                    const u32x4 yp = ypv[m][bj];
                    const f32x4 v0 = acc[ai][bj][m][0] + bv[bj][0], v1 = acc[ai][bj][m][1] + bv[bj][1];
                    u32x4 w;
                    w.x = cvt_pk_bf16(bflo(yp.x) * sigmoidf_(v0[0]), bfhi(yp.x) * sigmoidf_(v0[1])); w.y = cvt_pk_bf16(bflo(yp.y) * sigmoidf_(v0[2]), bfhi(yp.y) * sigmoidf_(v0[3]));
                    w.z = cvt_pk_bf16(bflo(yp.z) * sigmoidf_(v1[0]), bfhi(yp.z) * sigmoidf_(v1[1])); w.w = cvt_pk_bf16(bflo(yp.w) * sigmoidf_(v1[2]), bfhi(yp.w) * sigmoidf_(v1[3]));
                    *(u32x4*)(O + row * 1024 + 512 + c) = w;
                    asm volatile("" ::: "memory"); } }
            __builtin_amdgcn_sched_barrier(0);
        }
        return false;
    }
};
struct EpiGateUp {
    static constexpr bool PERM = true;
    bf16* O;
    __device__ __forceinline__ bool operator()(Acc& acc, const Unit& u, int wr, int wc, int fr, int fq) const {
        const int row0 = u.pm * BM + wr * 64 + fr, col0 = u.pn * HALF + wc * 32 + 8 * fq;
#pragma unroll
        for (int ai = 0; ai < 2; ++ai)
#pragma unroll
            for (int m = 0; m < 4; ++m) { const size_t row = (size_t)(row0 + ai * HALF + m * 16);
                const f32x4 g0 = acc[ai][0][m][0], g1 = acc[ai][0][m][1], u0 = acc[ai][1][m][0], u1 = acc[ai][1][m][1];
                float r[8];
#pragma unroll
                for (int j = 0; j < 4; ++j) { r[j] = g0[j] * sigmoidf_(g0[j]) * u0[j]; r[4 + j] = g1[j] * sigmoidf_(g1[j]) * u1[j]; }
                u32x4 w; w.x = cvt_pk_bf16(r[0], r[1]); w.y = cvt_pk_bf16(r[2], r[3]); w.z = cvt_pk_bf16(r[4], r[5]); w.w = cvt_pk_bf16(r[6], r[7]);
                *(u32x4*)(O + row * DFF + col0) = w; }
        return false;
    }
};

struct EpiGateUp8 {
    static constexpr bool PERM = true; static constexpr bool FP8 = true;
    unsigned char* O8;
    __device__ __forceinline__ bool operator()(Acc& acc, const Unit& u, int wr, int wc, int fr, int fq) const {
        const int row0 = u.pm * BM + wr * 64 + fr, col0 = u.pn * HALF + wc * 32 + 8 * fq;
#pragma unroll
        for (int ai = 0; ai < 2; ++ai)
#pragma unroll
            for (int m = 0; m < 4; ++m) { const size_t row = (size_t)(row0 + ai * HALF + m * 16);
                const f32x4 g0 = acc[ai][0][m][0] * 0.03125f, g1 = acc[ai][0][m][1] * 0.03125f, u0 = acc[ai][1][m][0] * 0.03125f, u1 = acc[ai][1][m][1] * 0.03125f;
                float r[8];
#pragma unroll
                for (int j = 0; j < 4; ++j) { r[j] = g0[j] * sigmoidf_(g0[j]) * u0[j]; r[4 + j] = g1[j] * sigmoidf_(g1[j]) * u1[j]; }
                int w0 = __builtin_amdgcn_cvt_pk_fp8_f32(16.f * r[0], 16.f * r[1], 0, false); w0 = __builtin_amdgcn_cvt_pk_fp8_f32(16.f * r[2], 16.f * r[3], w0, true);
                int w1 = __builtin_amdgcn_cvt_pk_fp8_f32(16.f * r[4], 16.f * r[5], 0, false); w1 = __builtin_amdgcn_cvt_pk_fp8_f32(16.f * r[6], 16.f * r[7], w1, true);
                *(u32x2*)(O8 + row * DFF + col0) = (u32x2){(unsigned)w0, (unsigned)w1}; }
        return false;
    }
};
struct EpiBf16S8 {
    static constexpr bool PERM = true; static constexpr bool FP8 = true;
    bf16* O; int ldc; float scale;
    __device__ __forceinline__ bool operator()(Acc& acc, const Unit& u, int wr, int wc, int fr, int fq) const {
        const int row0 = u.pm * BM + wr * 64 + fr, col0 = u.pn * BM + wc * 32 + 8 * fq;
#pragma unroll
        for (int ai = 0; ai < 2; ++ai)
#pragma unroll
            for (int m = 0; m < 4; ++m) { bf16* rowp = O + (size_t)(row0 + ai * HALF + m * 16) * ldc + col0;
#pragma unroll
                for (int bj = 0; bj < 2; ++bj) { const f32x4 v0 = acc[ai][bj][m][0] * scale, v1 = acc[ai][bj][m][1] * scale;
                    u32x4 w; w.x = cvt_pk_bf16(v0[0], v0[1]); w.y = cvt_pk_bf16(v0[2], v0[3]); w.z = cvt_pk_bf16(v1[0], v1[1]); w.w = cvt_pk_bf16(v1[2], v1[3]);
                    *(u32x4*)(rowp + bj * HALF) = w; } }
        return false;
    }
};

template <class Epi, class Sched>
__device__ __forceinline__ void gemm_phase(LAS unsigned char* lds, const int tid, const Sched& S, const Epi& E, const int K, const int lda, const int ldb) {
    const int wid = __builtin_amdgcn_readfirstlane(tid >> 6), lane = tid & 63, wr = wid >> 2, wc = wid & 3, fr = lane & 15, fq = lane >> 4;
    int nt = K / BK; asm volatile("" : "+s"(nt));
    constexpr bool GATHER = Sched::GATHER;
    unsigned voffA[2], voffB[2]; int gR[2], gC[2];
#pragma unroll
    for (int i = 0; i < 2; ++i) { int R, C; stage_rc(tid * 16 + i * 8192, R, C); const int Rb = Epi::PERM ? ((R & ~31) + perm32(R & 31)) : R; gR[i] = R; gC[i] = C;
        voffA[i] = (unsigned)(R * lda + C) * 2u; voffB[i] = (unsigned)(Rb * ldb + C) * 2u; }
    unsigned cvo[2][2], nvo[2][2];
#define PG8_GOFF(u_, out_) do { _Pragma("unroll") for (int _h = 0; _h < 2; ++_h) _Pragma("unroll") for (int _i = 0; _i < 2; ++_i) { const int _r = _h * HALF + gR[_i]; \
        const int _tok = (u_).amap[_r < (u_).avalid ? _r : (u_).avalid - 1]; out_[_h][_i] = (unsigned)_tok * (unsigned)(lda * 2) + (unsigned)gC[_i] * 2u; } } while (0)
#define PG8_STAGE_A(bufoff, base, h_, usenext) do { if constexpr (GATHER) { unsigned _vo[2]; _vo[0] = (usenext) ? nvo[h_][0] : cvo[h_][0]; _vo[1] = (usenext) ? nvo[h_][1] : cvo[h_][1]; PG8_STAGE(bufoff, base, _vo); } \
        else { PG8_STAGE(bufoff, (base) + (h_) * hstepA, voffA); } } while (0)
    const size_t kstep = (size_t)(BK * 2);
    const size_t hstepA = (size_t)HALF * lda * 2, hstepB = (size_t)HALF * ldb * 2;
    const unsigned ldsw = (unsigned)wid * 1024u;
    const int aoff = lds_byte(wr * 64 + fr, fq * 8), boff = lds_byte(wc * 32 + fr, fq * 8);
#define PG8_SA(b, h) (((b) * 2 + (h)) * HTB)
#define PG8_SB(b, h) ((4 + (b) * 2 + (h)) * HTB)
#define PG8_STAGE(bufoff, gbase, voff) do { _Pragma("unroll") for (int _i = 0; _i < 2; ++_i) \
        __builtin_amdgcn_global_load_lds((const unsigned*)((const char*)(gbase) + (voff)[_i]), (LAS unsigned*)(lds + (bufoff) + ldsw + _i * 8192), 16, 0, 0); } while (0)
#define PG8_LDA(dst, b, h) do { _Pragma("unroll") for (int m = 0; m < 4; ++m) { const i32x4_ lo_ = *(const LAS i32x4_*)(lds + PG8_SA(b, h) + aoff + m * 2048), hi_ = *(const LAS i32x4_*)(lds + PG8_SA(b, h) + aoff + m * 2048 + 1024); \
        dst[m] = __builtin_shufflevector(lo_, hi_, 0, 1, 2, 3, 4, 5, 6, 7); } } while (0)
#define PG8_LDB(dst, b, h) do { _Pragma("unroll") for (int n = 0; n < 2; ++n) { const i32x4_ lo_ = *(const LAS i32x4_*)(lds + PG8_SB(b, h) + boff + n * 2048), hi_ = *(const LAS i32x4_*)(lds + PG8_SB(b, h) + boff + n * 2048 + 1024); \
        dst[n] = __builtin_shufflevector(lo_, hi_, 0, 1, 2, 3, 4, 5, 6, 7); } } while (0)
#define PG8_K0(x) __builtin_bit_cast(bf16x8, __builtin_shufflevector(x, x, 0, 1, 2, 3))
#define PG8_K1(x) __builtin_bit_cast(bf16x8, __builtin_shufflevector(x, x, 4, 5, 6, 7))
#define PG8_MMA(ai, bj, At, Bt) do { __builtin_amdgcn_s_setprio(1); _Pragma("unroll") for (int m = 0; m < 4; ++m) _Pragma("unroll") for (int n = 0; n < 2; ++n) { \
        acc[ai][bj][m][n] = __builtin_amdgcn_mfma_f32_16x16x32_bf16(PG8_K0(Bt[n]), PG8_K0(At[m]), acc[ai][bj][m][n], 0, 0, 0); \
        acc[ai][bj][m][n] = __builtin_amdgcn_mfma_f32_16x16x32_bf16(PG8_K1(Bt[n]), PG8_K1(At[m]), acc[ai][bj][m][n], 0, 0, 0); } __builtin_amdgcn_s_setprio(0); } while (0)
#define PG8_MMA8(ai, bj, At, Bt) do { __builtin_amdgcn_s_setprio(1); _Pragma("unroll") for (int m = 0; m < 4; ++m) _Pragma("unroll") for (int n = 0; n < 2; ++n) \
        asm volatile("v_mfma_f32_16x16x128_f8f6f4 %0, %1, %2, %0" : "+v"(acc[ai][bj][m][n]) : "v"(Bt[n]), "v"(At[m])); __builtin_amdgcn_s_setprio(0); } while (0)
#define PG8_MM(ai, bj, At, Bt) do { if constexpr (EpiFp8<Epi>::v) { PG8_MMA8(ai, bj, At, Bt); } else { PG8_MMA(ai, bj, At, Bt); } } while (0)
#define PG8_WAIT_V(n) asm volatile("s_waitcnt vmcnt(" #n ")" ::: "memory")
#define PG8_WAIT_L(n) asm volatile("s_waitcnt lgkmcnt(" #n ")" ::: "memory")
#define PG8_BAR __builtin_amdgcn_s_barrier()
#define PG8_SCHED __builtin_amdgcn_sched_barrier(0)
    Unit cur, nxt; int ui = 0;
    if (!S.next(0, cur)) return;
    Acc acc;
#pragma unroll
    for (int a = 0; a < 2; ++a)
#pragma unroll
        for (int b = 0; b < 2; ++b)
#pragma unroll
            for (int m = 0; m < 4; ++m)
#pragma unroll
                for (int n = 0; n < 2; ++n) { float z_ = 0.f; if constexpr (EpiFp8<Epi>::v) asm volatile("" : "+v"(z_)); acc[a][b][m][n] = (f32x4){z_, z_, z_, z_}; }
    i32x8_ At[4], B0[2], B1[2];
    if constexpr (EpiFp8<Epi>::v) {
#pragma unroll
        for (int m = 0; m < 4; ++m) asm volatile("" : "=v"(At[m]));
#pragma unroll
        for (int n = 0; n < 2; ++n) { asm volatile("" : "=v"(B0[n])); asm volatile("" : "=v"(B1[n])); }
    }
    const char* cA = cur.A; const char* cB = cur.B;
    if constexpr (GATHER) { PG8_GOFF(cur, cvo); }
    PG8_STAGE(PG8_SB(0, 0), cB, voffB); PG8_STAGE(PG8_SB(0, 1), cB + hstepB, voffB); PG8_STAGE_A(PG8_SA(0, 0), cA, 0, false); PG8_STAGE_A(PG8_SA(0, 1), cA, 1, false);
    if (wr == 1) PG8_BAR;
    PG8_WAIT_V(2); PG8_BAR;
    PG8_STAGE(PG8_SB(1, 0), cB + kstep, voffB); PG8_STAGE_A(PG8_SA(1, 0), cA + kstep, 0, false); PG8_STAGE(PG8_SB(1, 1), cB + hstepB + kstep, voffB);
    PG8_WAIT_V(6); PG8_BAR;
    for (;;) {
        const bool has_next = S.next(ui + 1, nxt);
        const char* nA = has_next ? nxt.A : cA; const char* nB = has_next ? nxt.B : cB;
        if constexpr (GATHER) { if (has_next) { PG8_GOFF(nxt, nvo); } else {
#pragma unroll
                for (int _h = 0; _h < 2; ++_h) { nvo[_h][0] = cvo[_h][0]; nvo[_h][1] = cvo[_h][1]; } } }
        for (int t = 0; t < nt; t += 2) {
            const bool last = (t == nt - 2);
            const char* a1 = cA + (size_t)(t + 1) * kstep;
            const char* a2 = last ? nA : cA + (size_t)(t + 2) * kstep; const char* b2 = last ? nB : cB + (size_t)(t + 2) * kstep;
            const char* a3 = a2 + kstep; const char* b3 = b2 + kstep;
            PG8_LDB(B0, 0, 0); PG8_LDB(B1, 0, 1); PG8_SCHED; PG8_LDA(At, 0, 0); PG8_STAGE_A(PG8_SA(1, 1), a1, 1, false);
            PG8_WAIT_V(8); PG8_WAIT_L(0); PG8_BAR; PG8_MM(0, 0, At, B0); PG8_MM(0, 1, At, B1); PG8_BAR; PG8_SCHED;
            PG8_LDA(At, 0, 1); PG8_STAGE(PG8_SB(0, 0), b2, voffB); PG8_STAGE(PG8_SB(0, 1), b2 + hstepB, voffB); PG8_STAGE_A(PG8_SA(0, 0), a2, 0, last);
            PG8_WAIT_V(8); PG8_WAIT_L(0); PG8_BAR; PG8_MM(1, 0, At, B0); PG8_MM(1, 1, At, B1); PG8_BAR; PG8_SCHED;
            PG8_LDB(B0, 1, 0); PG8_LDB(B1, 1, 1); PG8_SCHED; PG8_LDA(At, 1, 0); PG8_STAGE_A(PG8_SA(0, 1), a2, 1, last);
            PG8_WAIT_V(8); PG8_WAIT_L(0); PG8_BAR; PG8_MM(0, 0, At, B0); PG8_MM(0, 1, At, B1); PG8_BAR; PG8_SCHED;
            PG8_LDA(At, 1, 1); PG8_STAGE(PG8_SB(1, 0), b3, voffB); PG8_STAGE(PG8_SB(1, 1), b3 + hstepB, voffB); PG8_STAGE_A(PG8_SA(1, 0), a3, 0, last);
            PG8_WAIT_V(8); PG8_WAIT_L(0); PG8_BAR; PG8_MM(1, 0, At, B0); PG8_MM(1, 1, At, B1); PG8_BAR; PG8_SCHED;
        }
        if (GEMM_ALIGN) { if (wr == 0) PG8_BAR; }
        if constexpr (EpiFp8<Epi>::v) {
#define PG8_ACC8(a, b) "+v"(acc[a][b][0][0]), "+v"(acc[a][b][0][1]), "+v"(acc[a][b][1][0]), "+v"(acc[a][b][1][1]), "+v"(acc[a][b][2][0]), "+v"(acc[a][b][2][1]), "+v"(acc[a][b][3][0]), "+v"(acc[a][b][3][1])
            asm volatile("s_nop 15\n\ts_nop 15\n\ts_nop 15\n\ts_nop 15\n\ts_nop 15" : PG8_ACC8(0, 0));
            asm volatile("" : PG8_ACC8(0, 1)); asm volatile("" : PG8_ACC8(1, 0)); asm volatile("" : PG8_ACC8(1, 1));
#undef PG8_ACC8
        }
        const bool keep = E(acc, cur, wr, wc, fr, fq);
        if (!has_next) break;
        if (!keep) {
#pragma unroll
            for (int a = 0; a < 2; ++a)
#pragma unroll
                for (int b = 0; b < 2; ++b)
#pragma unroll
                    for (int m = 0; m < 4; ++m)
#pragma unroll
                        for (int n = 0; n < 2; ++n) { float z_ = 0.f; if constexpr (EpiFp8<Epi>::v) asm volatile("" : "+v"(z_)); acc[a][b][m][n] = (f32x4){z_, z_, z_, z_}; }
        }
        cur = nxt; cA = nA; cB = nB; ++ui;
        if constexpr (GATHER) {
#pragma unroll
            for (int _h = 0; _h < 2; ++_h) { cvo[_h][0] = nvo[_h][0]; cvo[_h][1] = nvo[_h][1]; } }
        if (GEMM_ALIGN) { if (wr == 1) PG8_BAR; }
    }
    PG8_WAIT_V(0);
    if (!GEMM_ALIGN) { if (wr == 0) PG8_BAR; }
    PG8_BAR;
#undef PG8_SA
#undef PG8_SB
#undef PG8_STAGE
#undef PG8_STAGE_A
#undef PG8_GOFF
#undef PG8_LDA
#undef PG8_LDB
#undef PG8_MMA
#undef PG8_MMA8
#undef PG8_K0
#undef PG8_K1
#undef PG8_MM
#undef PG8_WAIT_V
#undef PG8_WAIT_L
#undef PG8_BAR
#undef PG8_SCHED
}
}

struct Args {
    const float* in[36]; float* out; unsigned char* ws; int ph_lo, ph_hi;
};
enum { I_X = 0, I_MEM, I_POS, I_NORM_MIX, I_W_IN, I_CONV_W, I_CONV_B, I_GLA_A_UP, I_GLA_A_B, I_GLA_NORM, I_S5_LRE, I_S5_LIM, I_S5_LOGDT, I_S5_BRE, I_S5_BIM, I_S5_CRE, I_S5_CIM, I_S5_D,
       I_S5_WGLU, I_S5_BGLU, I_W_BRANCH, I_W_OUT, I_NORM_CROSS, I_W_CQ, I_W_CKV, I_W_CO, I_NORM_FFN, I_W_RG, I_B_RG, I_W_RE, I_B_RE, I_W_EG, I_W_EU, I_W_ED, I_NORM_MEM, I_NORM_FINAL };

#define RELAUNDER_CTX(c0) Ctx c = (c0); { int _t = (c0).tid; asm volatile("" : "+v"(_t)); c.tid = _t; c.lane = _t & 63; c.wave = __builtin_amdgcn_readfirstlane(_t >> 6); }
struct Ctx { LAS unsigned char* lds; unsigned char* ws; int tid, lane, wave, G, vcu, gw, NGW, z, bx; };

template <class Src>
__device__ __forceinline__ void xpose_item(const Src& src, int ldw, bf16* WT, int ldt, int dst_k0, int kb, int nb, LAS float* scr, int lane, const float* kgain = nullptr, unsigned char* WT8 = nullptr) {
    const int k0 = 64 * kb, n0 = 32 * nb;
    const float* p = src(n0 + (lane & 31));
    float tv[32];
#pragma unroll
    for (int i = 0; i < 32; ++i) { const int kk = 2 * i + (lane >> 5); tv[i] = p ? p[(size_t)(k0 + kk) * ldw] : 0.f; }
#pragma unroll
    for (int i = 0; i < 32; ++i) { const int kk = 2 * i + (lane >> 5); scr[kk * 33 + (lane & 31)] = kgain ? tv[i] * kgain[k0 + kk] : tv[i]; }
    asm volatile("s_waitcnt lgkmcnt(0)" ::: "memory");
    const int c = lane & 7;
#pragma unroll
    for (int j = 0; j < 4; ++j) { const int n = (lane >> 3) + 8 * j; const LAS float* s = scr + (8 * c) * 33 + n;
        if (WT8) {
            int w0 = __builtin_amdgcn_cvt_pk_fp8_f32(32.f * s[0 * 33], 32.f * s[1 * 33], 0, false); w0 = __builtin_amdgcn_cvt_pk_fp8_f32(32.f * s[2 * 33], 32.f * s[3 * 33], w0, true);
            int w1 = __builtin_amdgcn_cvt_pk_fp8_f32(32.f * s[4 * 33], 32.f * s[5 * 33], 0, false); w1 = __builtin_amdgcn_cvt_pk_fp8_f32(32.f * s[6 * 33], 32.f * s[7 * 33], w1, true);
            *(u32x2*)(WT8 + (size_t)(n0 + n) * ldt + dst_k0 + k0 + 8 * c) = (u32x2){(unsigned)w0, (unsigned)w1};
        } else {
        u32x4 o; o.x = pk2(s[0 * 33], s[1 * 33]); o.y = pk2(s[2 * 33], s[3 * 33]); o.z = pk2(s[4 * 33], s[5 * 33]); o.w = pk2(s[6 * 33], s[7 * 33]);
        *(u32x4*)(WT + (size_t)(n0 + n) * ldt + dst_k0 + k0 + 8 * c) = o; } }
    asm volatile("s_waitcnt lgkmcnt(0)" ::: "memory");
}
struct SrcPlain { const float* W; __device__ __forceinline__ const float* operator()(int n) const { return W + n; } };
struct SrcWin { const float* W; __device__ __forceinline__ const float* operator()(int n) const {
        int c;
        if (n < 1792) c = n;
        else if (n < 2048) c = 1808 + (n - 1792);
        else if (n < 2304) c = 2064 + (n - 2048);
        else if (n < 2560) c = 2448 + (n - 2304);
        else if (n < 2624) c = 2320 + (n - 2560);
        else if (n < 2688) c = 2384 + (n - 2624);
        else if (n < 2720) c = 2704 + (n - 2688);
        else if (n < 2728) c = 2736 + (n - 2720);
        else if (n < 2736) c = -1;
        else if (n < 2752) c = 1792 + (n - 2736);
        else if (n < NPROJ) c = -1;
        else c = 2744 + (n - NPROJ);
        return c < 0 ? nullptr : W + c; } };
struct SrcGU { const float* Wg; const float* Wu; __device__ __forceinline__ const float* operator()(int n) const { const int pn = n >> 8, half = (n >> 7) & 1, j = n & 127; return Wg + (ptrdiff_t)half * (Wu - Wg) + 128 * pn + j; } };

__device__ __forceinline__ void conv_weights_nm(const Args& a, const Ctx& c, int l, int it) {
    LAS float* scr = (LAS float*)(c.lds + c.wave * 16384);
    unsigned char* wb = c.ws + WS_WNM + (size_t)l * WN_LAYER;
    int r = it;
    if (r < 16 * 216) { SrcWin s{a.in[I_W_IN + c.z] + (size_t)l * 1024 * D_IN}; const int nb = r % 216;
        xpose_item(s, D_IN, (bf16*)(wb + WN_IN), 1024, 0, r / 216, nb, scr, c.lane, nullptr, nb >= NPROJ / 32 ? wb + WN_IN + (size_t)NPROJ * 2048 - (size_t)NPROJ * 1024 : nullptr); return; } r -= 16 * 216;
    if (r < 512) { const int i = r >> 7, q = r & 127; SrcPlain s{a.in[I_W_BRANCH + c.z] + ((size_t)l * 4 + i) * 256 * 1024}; xpose_item(s, 1024, (bf16*)(wb + WN_BR), 1024, i * 256, q >> 5, q & 31, scr, c.lane); return; } r -= 512;
    if (r < 512) { SrcPlain s{a.in[I_W_OUT + c.z] + (size_t)l * 1024 * 1024}; xpose_item(s, 1024, (bf16*)(wb + WN_OUT), 1024, 0, r >> 5, r & 31, scr, c.lane); return; } r -= 512;
    if (r < 256) { SrcPlain s{a.in[I_W_CQ + c.z] + (size_t)l * 1024 * 512}; xpose_item(s, 512, (bf16*)(wb + WN_CQ), 1024, 0, r >> 4, r & 15, scr, c.lane, a.in[I_NORM_CROSS + c.z] + (size_t)l * 1024); return; } r -= 256;
    if (r < 512) { SrcPlain s{a.in[I_W_CKV + c.z] + (size_t)l * 1024 * 1024}; xpose_item(s, 1024, (bf16*)(wb + WN_CKV), 1024, 0, r >> 5, r & 31, scr, c.lane); return; } r -= 512;
    if (r < 256) { SrcPlain s{a.in[I_W_CO + c.z] + (size_t)l * 512 * 1024}; xpose_item(s, 1024, (bf16*)(wb + WN_CO), 512, 0, r >> 5, r & 31, scr, c.lane); return; } r -= 256;
    { SrcPlain s{a.in[I_S5_WGLU + c.z] + (size_t)l * 256 * 256}; xpose_item(s, 256, (bf16*)(wb + WN_GLU), 256, 0, r >> 3, r & 7, scr, c.lane); }
}
constexpr int NM_ITEMS = 16 * 216 + 512 + 512 + 256 + 512 + 256 + 32;
__device__ __forceinline__ void conv_weights_moe(const Args& a, const Ctx& c, int l, int it) {
    LAS float* scr = (LAS float*)(c.lds + c.wave * 16384);
    unsigned char* wb = c.ws + WS_WMOE;
    int r = it;
    if (r < 16 * 512) { const int e = r >> 9, q = r & 511; SrcGU s{a.in[I_W_EG + c.z] + ((size_t)l * 16 + e) * 1024 * 512, a.in[I_W_EU + c.z] + ((size_t)l * 16 + e) * 1024 * 512};
        xpose_item(s, 512, (bf16*)(wb + WM_GU), 1024, 0, q >> 5, q & 31, scr, c.lane, nullptr, wb + WM_GU + (size_t)e * 1024 * 1024); return; } r -= 16 * 512;
    { const int e = r >> 8, q = r & 255; SrcPlain s{a.in[I_W_ED + c.z] + ((size_t)l * 16 + e) * 512 * 1024}; xpose_item(s, 1024, (bf16*)(wb + WM_DN), 512, 0, q >> 5, q & 31, scr, c.lane, nullptr, wb + WM_DN + (size_t)e * 1024 * 512); }
}
constexpr int MOE_ITEMS = 16 * 512 + 16 * 256;

__device__ __forceinline__ void s5_tables_job(const Args& a, const Ctx& c, int job) {
    const int l = job >> 7, g = (job >> 3) & 15, part = job & 7;
    LAS f32x2* PW = (LAS f32x2*)(c.lds);
    LAS f32x2* BB = PW + 64 * 17;
    LAS f32x2* CC = BB + 64 * 16;
    __syncthreads();
    if (c.tid < 64) {
        const int p = c.tid;
        const double dt = exp((double)a.in[I_S5_LOGDT + c.z][l * 16 + g]);
        const double lr = (double)a.in[I_S5_LRE + c.z][(l * 16 + g) * 64 + p], li = (double)a.in[I_S5_LIM + c.z][(l * 16 + g) * 64 + p];
        const double mag = exp(lr * dt), br = mag * cos(li * dt), bi = mag * sin(li * dt);
        double xr = 1.0, xi = 0.0;
        for (int k = 0; k <= 16; ++k) { PW[p * 17 + k] = (f32x2){(float)xr, (float)xi}; const double nr = xr * br - xi * bi, ni = xr * bi + xi * br; xr = nr; xi = ni; }
        const double den = lr * lr + li * li;
        const double fr = ((br - 1.0) * lr + bi * li) / den, fi = (bi * lr - (br - 1.0) * li) / den;
        for (int ch = 0; ch < 16; ++ch) {
            const double b_re = (double)a.in[I_S5_BRE + c.z][((size_t)(l * 16 + g) * 64 + p) * 16 + ch], b_im = (double)a.in[I_S5_BIM + c.z][((size_t)(l * 16 + g) * 64 + p) * 16 + ch];
            BB[p * 16 + ch] = (f32x2){(float)(fr * b_re - fi * b_im), (float)(fr * b_im + fi * b_re)};
        }
        if (part == 0) ((f32x2*)(c.ws + WS_LAML))[(l * 16 + g) * 64 + p] = PW[p * 17 + 16];
    }
    for (int i = c.tid; i < 1024; i += NTHR) { const int ch = i >> 6, p = i & 63;
        CC[ch * 64 + p] = (f32x2){a.in[I_S5_CRE + c.z][((size_t)(l * 16 + g) * 16 + ch) * 64 + p], a.in[I_S5_CIM + c.z][((size_t)(l * 16 + g) * 16 + ch) * 64 + p]}; }
    __syncthreads();
    unsigned char* wb = c.ws + WS_WNM + (size_t)l * WN_LAYER;
    bf16* We = (bf16*)(wb + WN_S5E) + (size_t)g * 128 * 256;
    bf16* Bc = (bf16*)(wb + WN_S5B) + (size_t)g * 256 * 384;
    for (int i = c.tid; i < 16 * 256; i += NTHR) { const int q = 16 * part + (i >> 8), k = i & 255, s = k >> 4, ch = k & 15, p = q & 63;
        const f32x2 w = PW[p * 17 + 15 - s], b = BB[p * 16 + ch];
        const float v = (q < 64) ? (w.x * b.x - w.y * b.y) : (w.x * b.y + w.y * b.x);
        We[(size_t)q * 256 + k] = (bf16)f2bf(v); }
    for (int i = c.tid; i < 32 * 384; i += NTHR) { const int row = 32 * part + i / 384, k = i % 384, t = row >> 4, ch = row & 15;
        float v = 0.f;
        if (k < 256) { const int s = k >> 4, c2 = k & 15;
            if (s <= t) { for (int p = 0; p < 64; ++p) { const f32x2 cc = CC[ch * 64 + p], w = PW[p * 17 + (t - s)], b = BB[p * 16 + c2];
                    const float gr = cc.x * w.x - cc.y * w.y, gi = cc.x * w.y + cc.y * w.x; v += gr * b.x - gi * b.y; } } }
        else { const int p = (k - 256) & 63; const f32x2 cc = CC[ch * 64 + p], w = PW[p * 17 + t + 1];
            const float gr = cc.x * w.x - cc.y * w.y, gi = cc.x * w.y + cc.y * w.x; v = (k < 320) ? gr : -gi; }
        Bc[(size_t)row * 384 + k] = (bf16)f2bf(v); }
}

__device__ __forceinline__ void load_row(const float* xrow, int lane, f32x4 (&v)[4]) {
    const f32x4* xr = (const f32x4*)xrow + lane;
#pragma unroll
    for (int j = 0; j < 4; ++j) v[j] = xr[64 * j];
}
__device__ __forceinline__ float row_rstd(const f32x4 (&v)[4]) {
    float s = 0.f;
#pragma unroll
    for (int j = 0; j < 4; ++j) s += (v[j].x * v[j].x + v[j].y * v[j].y) + (v[j].z * v[j].z + v[j].w * v[j].w);
    return 1.f / sqrtf(wave_sum(s) * (1.f / 1024.f) + EPS);
}
__device__ __forceinline__ void store_row_bf16(bf16* orow, int lane, const f32x4 (&v)[4]) {
    u32x2* o8 = (u32x2*)orow + lane;
#pragma unroll
    for (int j = 0; j < 4; ++j) { u32x2 w; w.x = pk2(v[j].x, v[j].y); w.y = pk2(v[j].z, v[j].w); o8[64 * j] = w; }
}
template <int MODE, bool FINAL>
__device__ __forceinline__ void norm_phase(const Args& a, const Ctx& c, const float* gain, int lmoe = 0) {
    bf16* HY = (bf16*)(c.ws + WS_HY);
    f32x4 g[4]; load_row(gain, c.lane, g);
    const int* tokpos = (const int*)(c.ws + WS_TOKPOS); const float* tokw = (const float*)(c.ws + WS_TOKW); const bf16* OB = (const bf16*)(c.ws + WS_OB);
    constexpr int NR = (MODE == 2) ? 2 : 4;
    int seg[16];
    if (MODE == 2) { const unsigned* gcnt = (const unsigned*)(c.ws + WS_CTL) + CW_MOECNT + lmoe * 64; int acc = 0;
#pragma unroll
        for (int e = 0; e < 16; ++e) { seg[e] = acc * 256; acc += (int)((gcnt[e] + 255u) >> 8); } }
    for (int row0 = c.gw * NR; row0 < T; row0 += c.NGW * NR) {
        f32x4 v[NR][4];
        u32x2 q0[NR][4], q1[NR][4]; float w0[NR], w1[NR];
#pragma unroll
        for (int r = 0; r < NR; ++r) { const int row = row0 + r;
            if (MODE == 0) load_row(a.in[I_X + c.z] + (size_t)row * 1024, c.lane, v[r]); else load_row(a.out + (size_t)row * 1024, c.lane, v[r]);
            if (MODE == 2) { const int k0 = tokpos[2 * row], k1 = tokpos[2 * row + 1]; w0[r] = tokw[2 * row]; w1[r] = tokw[2 * row + 1];
                int p0 = k0 & 0xffffff, p1 = k1 & 0xffffff;
#pragma unroll
                for (int e = 0; e < 16; ++e) { if (((k0 >> 24) & 255) == e) p0 += seg[e]; if (((k1 >> 24) & 255) == e) p1 += seg[e]; }
                const u32x2* r0 = (const u32x2*)(OB + (size_t)p0 * 1024) + c.lane; const u32x2* r1 = (const u32x2*)(OB + (size_t)p1 * 1024) + c.lane;
#pragma unroll
                for (int j = 0; j < 4; ++j) { q0[r][j] = r0[64 * j]; q1[r][j] = r1[64 * j]; } } }
#pragma unroll
        for (int r = 0; r < NR; ++r) { const int row = row0 + r;
            if (MODE == 2) {
#pragma unroll
                for (int j = 0; j < 4; ++j) { const u32x2 a0 = q0[r][j], a1 = q1[r][j];
                    v[r][j].x += w0[r] * bflo(a0.x) + w1[r] * bflo(a1.x); v[r][j].y += w0[r] * bfhi(a0.x) + w1[r] * bfhi(a1.x);
                    v[r][j].z += w0[r] * bflo(a0.y) + w1[r] * bflo(a1.y); v[r][j].w += w0[r] * bfhi(a0.y) + w1[r] * bfhi(a1.y); }
                if (!FINAL) { f32x4* o = (f32x4*)(a.out + (size_t)row * 1024) + c.lane;
#pragma unroll
                    for (int j = 0; j < 4; ++j) o[64 * j] = v[r][j]; }
            }
            const float rstd = row_rstd(v[r]);
#pragma unroll
            for (int j = 0; j < 4; ++j) v[r][j] = v[r][j] * rstd * g[j];
            if (FINAL) { f32x4* o = (f32x4*)(a.out + (size_t)row * 1024) + c.lane;
#pragma unroll
                for (int j = 0; j < 4; ++j) o[64 * j] = v[r][j]; }
            else { store_row_bf16(HY + (size_t)row * 1024, c.lane, v[r]);
                if (MODE != 1) { int* o8 = (int*)(c.ws + WS_H8 + (size_t)row * 1024) + c.lane;
#pragma unroll
                    for (int j = 0; j < 4; ++j) { int w = __builtin_amdgcn_cvt_pk_fp8_f32(v[r][j].x, v[r][j].y, 0, false); w = __builtin_amdgcn_cvt_pk_fp8_f32(v[r][j].z, v[r][j].w, w, true); o8[64 * j] = w; } } }
        }
    }
}
__device__ __forceinline__ void memn_phase(const Args& a, const Ctx& c) {
    bf16* MN = (bf16*)(c.ws + WS_MEMN);
    f32x4 g[4]; load_row(a.in[I_NORM_MEM + c.z], c.lane, g);
    for (int row = c.gw; row < MROWS; row += c.NGW) {
        f32x4 v[4]; load_row(a.in[I_MEM + c.z] + (size_t)row * 1024, c.lane, v);
        const float rstd = row_rstd(v);
#pragma unroll
        for (int j = 0; j < 4; ++j) v[j] = v[j] * rstd * g[j];
        store_row_bf16(MN + (size_t)row * 1024, c.lane, v);
    }
}

__device__ __forceinline__ void ffn_norm_route_phase(const Args& a, const Ctx& c, int l) {
    bf16* HY = (bf16*)(c.ws + WS_HY);
    int* tokpos = (int*)(c.ws + WS_TOKPOS); float* tokw = (float*)(c.ws + WS_TOKW); int* rowmap = (int*)(c.ws + WS_ROWMAP);
    unsigned* gcnt = (unsigned*)(c.ws + WS_CTL) + CW_MOECNT + l * 64;
    LAS int* lcnt = (LAS int*)(c.lds + 140000);
    LAS int* lrow = (LAS int*)(c.lds + 140000 + 256);
    const float* gain = a.in[I_NORM_FFN + c.z] + (size_t)l * 1024;
    const float* wrg = a.in[I_W_RG + c.z] + (size_t)l * 1024 * 4; const float* wre = a.in[I_W_RE + c.z] + (size_t)l * 1024 * 16;
    const float* brg = a.in[I_B_RG + c.z] + l * 4; const float* bre = a.in[I_B_RE + c.z] + l * 16;
    f32x4 g[4]; load_row(gain, c.lane, g);
    const int rows_per = (T + c.G - 1) / c.G;
    for (int base = c.bx * rows_per; base < T; base += c.G * rows_per) {
        __syncthreads();
        if (c.tid < 32) lcnt[c.tid] = 0;
        __syncthreads();
        LAS float* WRE = (LAS float*)c.lds;
        for (int i = c.tid; i < 4 * 16 * 64; i += NTHR) { const int gq = i >> 10, je = (i >> 6) & 15, ln = i & 63; const int k = 4 * ln + 256 * (je >> 2) + (je & 3);
            *(LAS f32x4*)(WRE + (size_t)i * 4) = *(const f32x4*)(wre + (size_t)k * 16 + 4 * gq); }
        __syncthreads();
        f32x4 wgv[4][4];
#pragma unroll
        for (int j = 0; j < 4; ++j)
#pragma unroll
            for (int e = 0; e < 4; ++e) wgv[j][e] = *(const f32x4*)(wrg + (size_t)(4 * c.lane + 256 * j + e) * 4);
        f32x4 vpre[4]; if (c.wave < rows_per && base + c.wave < T) load_row(a.out + (size_t)(base + c.wave) * 1024, c.lane, vpre);
#pragma unroll 1
        for (int lr = c.wave; lr < rows_per && base + lr < T; lr += NWAVES) {
            const int row = base + lr;
            f32x4 v[4];
#pragma unroll
            for (int j = 0; j < 4; ++j) v[j] = vpre[j];
            { const int ln = lr + NWAVES; const int rn = (ln < rows_per && base + ln < T) ? base + ln : row; load_row(a.out + (size_t)rn * 1024, c.lane, vpre); }
            const float rstd = row_rstd(v);
#pragma unroll
            for (int j = 0; j < 4; ++j) v[j] = v[j] * rstd * g[j];
            { int* o8 = (int*)(c.ws + WS_H8F + (size_t)row * 1024) + c.lane;
#pragma unroll
              for (int jq = 0; jq < 4; ++jq) { int w = __builtin_amdgcn_cvt_pk_fp8_f32(v[jq].x, v[jq].y, 0, false); w = __builtin_amdgcn_cvt_pk_fp8_f32(v[jq].z, v[jq].w, w, true); o8[64 * jq] = w; } }
            float gl[4] = {0.f, 0.f, 0.f, 0.f};
#pragma unroll
            for (int j = 0; j < 4; ++j) {
#pragma unroll
                for (int e = 0; e < 4; ++e) { const f32x4 w = wgv[j][e];
                    const float hv = v[j][e]; gl[0] += hv * w.x; gl[1] += hv * w.y; gl[2] += hv * w.z; gl[3] += hv * w.w; } }
#pragma unroll
            for (int q = 0; q < 4; ++q) gl[q] = wave_sum(gl[q]) + brg[q];
            int gs = 0; float gm = gl[0];
#pragma unroll
            for (int q = 1; q < 4; ++q) if (gl[q] > gm) { gm = gl[q]; gs = q; }
            float gsum = 0.f;
#pragma unroll
            for (int q = 0; q < 4; ++q) gsum += __expf(gl[q] - gm);
            const float pg = 1.f / gsum;
            float el[4] = {0.f, 0.f, 0.f, 0.f};
#pragma unroll
            for (int j = 0; j < 4; ++j) {
#pragma unroll
                for (int e = 0; e < 4; ++e) { const f32x4 w = *(const LAS f32x4*)(WRE + ((size_t)(gs * 16 + j * 4 + e) * 64 + c.lane) * 4);
                    const float hv = v[j][e]; el[0] += hv * w.x; el[1] += hv * w.y; el[2] += hv * w.z; el[3] += hv * w.w; } }
#pragma unroll
            for (int q = 0; q < 4; ++q) el[q] = wave_sum(el[q]) + bre[4 * gs + q];
            int i0 = 0; float m0 = el[0];
#pragma unroll
            for (int q = 1; q < 4; ++q) if (el[q] > m0) { m0 = el[q]; i0 = q; }
            int i1 = -1; float m1 = -3.0e38f;
#pragma unroll
            for (int q = 0; q < 4; ++q) if (q != i0 && el[q] > m1) { m1 = el[q]; i1 = q; }
            const float e1 = __expf(m1 - m0); const float t0 = 1.f / (1.f + e1), t1 = e1 * t0;
            if (c.lane == 0) {
                const int e0x = gs * 4 + i0, e1x = gs * 4 + i1;
                const int r0 = atomicAdd((int*)&lcnt[e0x], 1), r1 = atomicAdd((int*)&lcnt[e1x], 1);
                lrow[lr * 4 + 0] = e0x; lrow[lr * 4 + 1] = e1x; lrow[lr * 4 + 2] = r0; lrow[lr * 4 + 3] = r1;
                tokw[2 * row] = pg * t0; tokw[2 * row + 1] = pg * t1;
            }
        }
        __syncthreads();
        if (c.tid < 16) { const int n = lcnt[c.tid]; lcnt[16 + c.tid] = n ? (int)atomicAdd(gcnt + c.tid, (unsigned)n) : 0; }
        __syncthreads();
        for (int lr = c.tid; lr < rows_per && base + lr < T; lr += NTHR) {
            const int row = base + lr; const int e0x = lrow[lr * 4], e1x = lrow[lr * 4 + 1];
            const int i0x = lcnt[16 + e0x] + lrow[lr * 4 + 2], i1x = lcnt[16 + e1x] + lrow[lr * 4 + 3];
            tokpos[2 * row] = (e0x << 24) | i0x; tokpos[2 * row + 1] = (e1x << 24) | i1x;
            rowmap[(size_t)e0x * CAPE + i0x] = row; rowmap[(size_t)e1x * CAPE + i1x] = row;
        }
    }
}
__device__ __forceinline__ void moe_tables(const Ctx& c, int l, LAS int* tb) {
    const unsigned* gcnt = (const unsigned*)(c.ws + WS_CTL) + CW_MOECNT + l * 64;
    __syncthreads();
    if (c.tid < 16) tb[17 + c.tid] = (int)gcnt[c.tid];
    __syncthreads();
    if (c.tid == 0) { int acc = 0; tb[0] = 0; for (int e = 0; e < 16; ++e) { acc += (tb[17 + e] + 255) >> 8; tb[e + 1] = acc; } }
    __syncthreads();
}
#ifndef DPP_U
#define DPP_U(v, old, ctrl) ((unsigned)__builtin_amdgcn_update_dpp((int)(old), (int)(v), (ctrl), 0xF, 0xF, false))
#endif

struct TokRaw { u32x2 h0, c0, h1, c1, h2, c2, bg; int pos; unsigned qa, qb_, qs[3], w, ia, ib, is[3], ka, kb_, kx, vx; };
__device__ __forceinline__ void token_load(const Ctx& c, const int* pos, int t, TokRaw& R) {
    const bf16* P = (const bf16*)(c.ws + WS_PROJ);
#define PR(tt, col) (P + POFF((tt), (col)))
    const int s = t & (SEQ - 1), t1 = s >= 1 ? t - 1 : t, t2 = s >= 2 ? t - 2 : t, j8 = c.lane & 7;
    R.h0 = *(const u32x2*)(PR(t, C_CH) + 4 * c.lane); R.c0 = *(const u32x2*)(PR(t, C_CC) + 4 * c.lane);
    R.h1 = *(const u32x2*)(PR(t1, C_CH) + 4 * c.lane); R.c1 = *(const u32x2*)(PR(t1, C_CC) + 4 * c.lane);
    R.h2 = *(const u32x2*)(PR(t2, C_CH) + 4 * c.lane); R.c2 = *(const u32x2*)(PR(t2, C_CC) + 4 * c.lane);
    R.bg = *(const u32x2*)(PR(t, C_CB) + 4 * c.lane);
    R.pos = pos[t];
    { const bf16* q = (c.lane < 32) ? PR(t, C_DQ) + (c.lane >> 3) * 64 + j8 : PR(t, C_DK) + j8; R.qa = q[0]; R.qb_ = q[8]; }
#pragma unroll
    for (int i = 0; i < 3; ++i) { const int e = c.lane + 64 * i, hd = e / 48, dd = 16 + e % 48; R.qs[i] = PR(t, C_DQ)[hd * 64 + dd]; }
    const int hh = c.lane >> 3;
    R.w = PR(t, C_IW)[hh];
    { const bf16* q = PR(t, C_IQ) + hh * 32; const int j = c.lane & 3; R.ia = q[j]; R.ib = q[j + 4];
#pragma unroll
      for (int i = 0; i < 3; ++i) R.is[i] = q[8 + j8 * 3 + i]; }
    { const bf16* k = PR(t, C_IK); const int j = c.lane & 3; R.ka = k[j]; R.kb_ = k[j + 4]; }
    R.vx = PR(t, C_DV)[c.lane];
    R.kx = PR(t, C_DK)[c.lane];
#undef PR
}
__device__ __forceinline__ void token_prep_phase(const Args& a, const Ctx& c, int l) {
    bf16* P = (bf16*)(c.ws + WS_PROJ); bf16* HY = (bf16*)(c.ws + WS_HY);
    const int* pos = (const int*)a.in[I_POS + c.z];
    const float* cw = a.in[I_CONV_W + c.z] + (size_t)l * 3 * 256; const float* cb = a.in[I_CONV_B + c.z] + (size_t)l * 256;
    const f32x4 w0 = *(const f32x4*)(cw + 4 * c.lane), w1 = *(const f32x4*)(cw + 256 + 4 * c.lane), w2 = *(const f32x4*)(cw + 512 + 4 * c.lane), wb = *(const f32x4*)(cb + 4 * c.lane);
    const int j8 = c.lane & 7;
    const float invf = powf(500000.f, -(float)j8 * 0.125f);
    int t = c.gw; if (t >= T) return;
    TokRaw cur; token_load(c, pos, t, cur);
#pragma unroll 1
    for (; t < T; t += c.NGW) {
#define PR(tt, col) (P + POFF((tt), (col)))
        TokRaw nxt; { const int tn = t + c.NGW; token_load(c, pos, tn < T ? tn : t, nxt); }
        const TokRaw& R = cur;
        const int s = t & (SEQ - 1);
        {
            const f32x4 u0 = {bflo(R.h0.x) * bflo(R.c0.x), bfhi(R.h0.x) * bfhi(R.c0.x), bflo(R.h0.y) * bflo(R.c0.y), bfhi(R.h0.y) * bfhi(R.c0.y)};
            f32x4 u1 = {bflo(R.h1.x) * bflo(R.c1.x), bfhi(R.h1.x) * bfhi(R.c1.x), bflo(R.h1.y) * bflo(R.c1.y), bfhi(R.h1.y) * bfhi(R.c1.y)};
            f32x4 u2 = {bflo(R.h2.x) * bflo(R.c2.x), bfhi(R.h2.x) * bfhi(R.c2.x), bflo(R.h2.y) * bflo(R.c2.y), bfhi(R.h2.y) * bfhi(R.c2.y)};
            if (s < 1) u1 = (f32x4){0.f, 0.f, 0.f, 0.f};
            if (s < 2) u2 = (f32x4){0.f, 0.f, 0.f, 0.f};
            const f32x4 y = w0 * u2 + w1 * u1 + w2 * u0 + wb;
            u32x2 o; o.x = pk2(bflo(R.bg.x) * y.x, bfhi(R.bg.x) * y.y); o.y = pk2(bflo(R.bg.y) * y.z, bfhi(R.bg.y) * y.w);
            *(u32x2*)(HY + (size_t)t * 1024 + 4 * c.lane) = o;
        }
        const float ang = (float)R.pos * invf;
        float sn, cs; sincosf(ang, &sn, &cs);
        { const float x1 = bf2f(R.qa), x2 = bf2f(R.qb_);
          if (c.lane < 32) { bf16* q = PR(t, C_DQ) + (c.lane >> 3) * 64 + j8; q[0] = (bf16)f2bf((x1 * cs - x2 * sn) * 0.125f); q[8] = (bf16)f2bf((x2 * cs + x1 * sn) * 0.125f); }
          else if (c.lane < 40) { bf16* k = PR(t, C_DK) + j8; k[0] = (bf16)f2bf(x1 * cs - x2 * sn); k[8] = (bf16)f2bf(x2 * cs + x1 * sn); }
          const float r0 = bf2f(f2bf(x1 * cs - x2 * sn)), r8 = bf2f(f2bf(x2 * cs + x1 * sn));
          const float v0 = __shfl(r0, 32 + j8), v8 = __shfl(r8, 32 + j8);
          const float kval = c.lane < 8 ? v0 : (c.lane < 16 ? v8 : bf2f(R.kx));
          const float k1 = __uint_as_float(DPP_U(__float_as_uint(kval), __float_as_uint(kval), 0x55)), k2 = __uint_as_float(DPP_U(__float_as_uint(kval), __float_as_uint(kval), 0xAA)),
                      k3 = __uint_as_float(DPP_U(__float_as_uint(kval), __float_as_uint(kval), 0xFF));
          int w8 = __builtin_amdgcn_cvt_pk_fp8_f32(kval, k1, 0, false); w8 = __builtin_amdgcn_cvt_pk_fp8_f32(k2, k3, w8, true);
          if ((c.lane & 3) == 0) *(int*)(c.ws + WS_K8 + (size_t)t * 64 + c.lane) = w8;
          const float vval = bf2f(R.vx);
          const float u1 = __uint_as_float(DPP_U(__float_as_uint(vval), __float_as_uint(vval), 0x55)), u2 = __uint_as_float(DPP_U(__float_as_uint(vval), __float_as_uint(vval), 0xAA)),
                      u3 = __uint_as_float(DPP_U(__float_as_uint(vval), __float_as_uint(vval), 0xFF));
          int x8 = __builtin_amdgcn_cvt_pk_fp8_f32(vval, u1, 0, false); x8 = __builtin_amdgcn_cvt_pk_fp8_f32(u2, u3, x8, true);
          if ((c.lane & 3) == 0) *(int*)(c.ws + WS_V8 + (size_t)t * 64 + c.lane) = x8; }
#pragma unroll
        for (int i = 0; i < 3; ++i) { const int e = c.lane + 64 * i, hd = e / 48, dd = 16 + e % 48; PR(t, C_DQ)[hd * 64 + dd] = (bf16)f2bf(bf2f(R.qs[i]) * 0.125f); }
        const float cs4 = __shfl(cs, 2 * (c.lane & 3)), sn4 = __shfl(sn, 2 * (c.lane & 3));
        const float wsc = 0.0625f;
        const int hh = c.lane >> 3;
        const float wh = bf2f(R.w); const float aw = fabsf(wh) * wsc;
        {   bf16* q = PR(t, C_IQ) + hh * 32;
            const float sgn = wh < 0.f ? -1.f : 1.f;
            float sl[5];
            { const int j = c.lane & 3; const float x1 = bf2f(R.ia), x2 = bf2f(R.ib);
              const bf16 o1 = (bf16)f2bf((x1 * cs4 - x2 * sn4) * aw), o2 = (bf16)f2bf((x2 * cs4 + x1 * sn4) * aw);
              if ((c.lane & 7) < 4) { q[j] = o1; q[j + 4] = o2; }
              sl[0] = sgn * bf2f(o1); sl[1] = sgn * bf2f(o2); }
#pragma unroll
            for (int i = 0; i < 3; ++i) { const int dd = 8 + (c.lane & 7) * 3 + i; const bf16 o = (bf16)f2bf(bf2f(R.is[i]) * aw); q[dd] = o; sl[2 + i] = sgn * bf2f(o); }
#pragma unroll
            for (int i = 0; i < 5; ++i) { sl[i] += __shfl_xor(sl[i], 8); sl[i] += __shfl_xor(sl[i], 16); sl[i] += __shfl_xor(sl[i], 32); }
            if (c.lane < 8) { bf16* ql = PR(t, C_IL);
                if (c.lane < 4) { ql[c.lane] = (bf16)f2bf(sl[0]); ql[c.lane + 4] = (bf16)f2bf(sl[1]); }
#pragma unroll
                for (int i = 0; i < 3; ++i) ql[8 + c.lane * 3 + i] = (bf16)f2bf(sl[2 + i]); }
        }
        if (c.lane < 4) { bf16* k = PR(t, C_IK); const int j = c.lane; const float x1 = bf2f(R.ka), x2 = bf2f(R.kb_);
            k[j] = (bf16)f2bf(x1 * cs4 - x2 * sn4); k[j + 4] = (bf16)f2bf(x2 * cs4 + x1 * sn4); }
        if ((c.lane & 7) == 0) PR(t, C_IW)[hh] = (bf16)(wh < 0.f ? 0xBF80u : 0x3F80u);
        cur = nxt;
#undef PR
    }
}

constexpr int GL_QD = 0, GL_KI = 9216, GL_KET = 18432, GL_VT = 27648, GL_ATT = 36864, GL_ST = 46080, GL_AL = 55296  , GL_PART = 59392  , GL_OF = 61440  ;
struct GlaCommon { float bc[8]; float blast; };
struct GlaW { float au[16]; float ab; float gn; };
template <int PH> struct GlaRaw { unsigned al; unsigned k[8], v[8], q[PH == 3 ? 8 : 1], r[PH == 3 ? 8 : 1]; float st[PH == 3 ? 8 : 1]; };
__device__ __forceinline__ void gla_load_w(const Args& a, const Ctx& c, int l, int h, GlaW& W) {
#pragma unroll
    for (int r = 0; r < 16; ++r) W.au[r] = a.in[I_GLA_A_UP + c.z][((size_t)l * 16 + r) * 256 + h * 64 + c.lane];
    W.ab = a.in[I_GLA_A_B + c.z][l * 256 + h * 64 + c.lane]; W.gn = a.in[I_GLA_NORM + c.z][l * 256 + h * 64 + c.lane];
}
template <int PH>
__device__ __forceinline__ void gla_load(const Ctx& c, int task, GlaRaw<PH>& R) {
    const bf16* P = (const bf16*)(c.ws + WS_PROJ);
    const int h = task & 3, tok0 = (task >> 2) * 64;
    { const int idx = c.tid * 2, j = idx >> 4, r = idx & 15; R.al = *(const unsigned*)(P + POFF(tok0 + j, C_GA) + r); }
#pragma unroll
    for (int jj = 0; jj < 8; ++jj) { const size_t ro = (size_t)(tok0 + c.wave * 8 + jj) * 256 + h * 64 + c.lane;
        R.k[jj] = P[ro + POFF(0, C_GK)]; R.v[jj] = P[ro + POFF(0, C_GV)];
        if (PH == 3) { R.q[jj] = P[ro + POFF(0, C_GQ)]; R.r[jj] = P[ro + POFF(0, C_GR)]; R.st[jj] = ((const float*)(c.ws + WS_GSLOC))[(size_t)task * 4096 + (c.wave * 8 + jj) * 64 + c.lane]; } }
}
__device__ __forceinline__ void gla_decay(const Ctx& c, unsigned alw, const GlaW& W, GlaCommon& gc) {
    LAS float* AL = (LAS float*)(c.lds + GL_AL); LAS float* PART = (LAS float*)(c.lds + GL_PART);
    { const int idx = c.tid * 2; AL[idx] = bflo(alw); AL[idx + 1] = bfhi(alw); }
    lds_barrier();
    float run = 0.f;
    f32x4 alc[4];
#pragma unroll
    for (int r4 = 0; r4 < 4; ++r4) alc[r4] = *(const LAS f32x4*)(AL + (c.wave * 8) * 16 + 4 * r4);
#pragma unroll
    for (int jj = 0; jj < 8; ++jj) { float z = W.ab;
        f32x4 aln[4];
        if (jj < 7) {
#pragma unroll
            for (int r4 = 0; r4 < 4; ++r4) aln[r4] = *(const LAS f32x4*)(AL + (c.wave * 8 + jj + 1) * 16 + 4 * r4); }
        __builtin_amdgcn_sched_barrier(0);
#pragma unroll
        for (int r4 = 0; r4 < 4; ++r4) { const f32x4 al = alc[r4]; z += al.x * W.au[4 * r4] + al.y * W.au[4 * r4 + 1] + al.z * W.au[4 * r4 + 2] + al.w * W.au[4 * r4 + 3]; }
        const float ls = fminf(z, 0.f) - 0.69314718056f * __builtin_amdgcn_logf(1.f + __expf(-fabsf(z)));
        run += ls * (1.f / 16.f); gc.bc[jj] = run;
        if (jj < 7) {
#pragma unroll
            for (int r4 = 0; r4 < 4; ++r4) alc[r4] = aln[r4]; }
        __builtin_amdgcn_sched_barrier(0); }
    PART[c.wave * 64 + c.lane] = run;
    lds_barrier();
    float off = 0.f, tot = 0.f;
#pragma unroll
    for (int w = 0; w < 8; ++w) { const float p = PART[w * 64 + c.lane]; tot += p; if (w < c.wave) off += p; }
#pragma unroll
    for (int jj = 0; jj < 8; ++jj) gc.bc[jj] += off;
    gc.blast = tot;
}
__device__ __forceinline__ f32x4 mma2(const LAS bf16* Ab, const LAS bf16* Bb, int lane, f32x4 acc) {
    const int fr = lane & 15, fq = lane >> 4;
#pragma unroll
    for (int ks = 0; ks < 2; ++ks) { const bf16x8 av = *(const LAS bf16x8*)(Ab + fr * 72 + 32 * ks + 8 * fq), bv = *(const LAS bf16x8*)(Bb + fr * 72 + 32 * ks + 8 * fq);
        acc = __builtin_amdgcn_mfma_f32_16x16x32_bf16(av, bv, acc, 0, 0, 0); }
    return acc;
}
__device__ __forceinline__ void gla1_compute(const Ctx& c, int task, const GlaRaw<1>& R, const GlaW& W) {
    GlaCommon gc; gla_decay(c, R.al, W, gc);
    LAS bf16* KET = (LAS bf16*)(c.lds + GL_KET); LAS bf16* VT = (LAS bf16*)(c.lds + GL_VT);
    unsigned kp[4], vp[4];
#pragma unroll
    for (int jj = 0; jj < 8; jj += 2) {
        const float k0 = bf2f(R.k[jj]) * __expf(gc.blast - gc.bc[jj]), k1 = bf2f(R.k[jj + 1]) * __expf(gc.blast - gc.bc[jj + 1]);
        kp[jj >> 1] = pk2(k0, k1); vp[jj >> 1] = R.v[jj] | (R.v[jj + 1] << 16); }
    *(LAS u32x4*)(KET + c.lane * 72 + c.wave * 8) = (u32x4){kp[0], kp[1], kp[2], kp[3]};
    *(LAS u32x4*)(VT + c.lane * 72 + c.wave * 8) = (u32x4){vp[0], vp[1], vp[2], vp[3]};
    if (c.wave == 0) ((float*)(c.ws + WS_GDEC))[(size_t)task * 64 + c.lane] = __expf(gc.blast);
    lds_barrier();
    float* Sl = (float*)(c.ws + WS_GSLOC) + (size_t)task * 4096;
    const int eb = c.wave >> 1, fr = c.lane & 15, fq = c.lane >> 4;
#pragma unroll
    for (int q = 0; q < 2; ++q) { const int db = (c.wave & 1) * 2 + q;
        f32x4 acc = {0.f, 0.f, 0.f, 0.f}; acc = mma2(VT + eb * 16 * 72, KET + db * 16 * 72, c.lane, acc);
#pragma unroll
        for (int r = 0; r < 4; ++r) Sl[(eb * 16 + 4 * fq + r) * 64 + db * 16 + fr] = acc[r]; }
    lds_barrier();
}
__device__ __forceinline__ void gla3_compute(const Ctx& c, int task, const GlaRaw<3>& R, const GlaW& W) {
    bf16* HY = (bf16*)(c.ws + WS_HY);
    const int h = task & 3, tok0 = (task >> 2) * 64;
    GlaCommon gc; gla_decay(c, R.al, W, gc);
    LAS bf16* QD = (LAS bf16*)(c.lds + GL_QD); LAS bf16* KI = (LAS bf16*)(c.lds + GL_KI); LAS bf16* VT = (LAS bf16*)(c.lds + GL_VT);
    LAS bf16* ATT = (LAS bf16*)(c.lds + GL_ATT); LAS bf16* ST = (LAS bf16*)(c.lds + GL_ST); LAS float* OF = (LAS float*)(c.lds + GL_OF);
    unsigned vp[4];
#pragma unroll
    for (int jj = 0; jj < 8; ++jj) { const int j = c.wave * 8 + jj;
        const float q = bf2f(R.q[jj]) * 0.125f * __expf(gc.bc[jj]); const float k = bf2f(R.k[jj]) * __expf(-gc.bc[jj]);
        QD[j * 72 + c.lane] = (bf16)f2bf(q); KI[j * 72 + c.lane] = (bf16)f2bf(k);
        if (jj & 1) vp[jj >> 1] |= R.v[jj] << 16; else vp[jj >> 1] = R.v[jj];
        ST[j * 72 + c.lane] = (bf16)f2bf(R.st[jj]); }
    *(LAS u32x4*)(VT + c.lane * 72 + c.wave * 8) = (u32x4){vp[0], vp[1], vp[2], vp[3]};
    lds_barrier();
    const int ib = c.wave >> 1, fr = c.lane & 15, fq = c.lane >> 4;
#pragma unroll
    for (int q = 0; q < 2; ++q) { const int jb = (c.wave & 1) * 2 + q;
        f32x4 acc = {0.f, 0.f, 0.f, 0.f};
        if (jb <= ib) acc = mma2(QD + ib * 16 * 72, KI + jb * 16 * 72, c.lane, acc);
#pragma unroll
        for (int r = 0; r < 4; ++r) { const int i = ib * 16 + 4 * fq + r, j = jb * 16 + fr; ATT[i * 72 + j] = (bf16)f2bf(j <= i ? acc[r] : 0.f); } }
    lds_barrier();
#pragma unroll
    for (int q = 0; q < 2; ++q) { const int eb = (c.wave & 1) * 2 + q;
        f32x4 acc = {0.f, 0.f, 0.f, 0.f};
        acc = mma2(ATT + ib * 16 * 72, VT + eb * 16 * 72, c.lane, acc);
        acc = mma2(QD + ib * 16 * 72, ST + eb * 16 * 72, c.lane, acc);
#pragma unroll
        for (int r = 0; r < 4; ++r) OF[(ib * 16 + 4 * fq + r) * 65 + eb * 16 + fr] = acc[r]; }
    lds_barrier();
#pragma unroll
    for (int jj = 0; jj < 8; ++jj) { const int i = c.wave * 8 + jj; const float o = OF[i * 65 + c.lane];
        const float ss = wave_sum(o * o); const float rr = bf2f(R.r[jj]);
        const float y = o * (1.f / sqrtf(ss * (1.f / 64.f) + EPS)) * W.gn * (rr * sigmoidf_(rr));
        HY[(size_t)(tok0 + i) * 1024 + 256 + h * 64 + c.lane] = (bf16)f2bf(y); }
    lds_barrier();
}
template <int PH>
__device__ __forceinline__ void gla_tasks(const Args& a, const Ctx& c0, int l) {
    RELAUNDER_CTX(c0);
    GlaW W; gla_load_w(a, c, l, c.bx & 3, W);
    int task = c.bx; if (task >= 2048) return;
    GlaRaw<PH> cur; gla_load<PH>(c, task, cur);
#pragma unroll 1
    for (; task < 2048; task += c.G) {
        const int tn = task + c.G; GlaRaw<PH> nxt; gla_load<PH>(c, tn < 2048 ? tn : task, nxt);
        if (c.G & 3) gla_load_w(a, c, l, task & 3, W);
        if (PH == 1) gla1_compute(c, task, (const GlaRaw<1>&)cur, W); else gla3_compute(c, task, (const GlaRaw<3>&)cur, W);
        cur = nxt;
    }
}
__device__ __forceinline__ void gla2_phase(const Args& a, const Ctx& c) {
    float* Sl = (float*)(c.ws + WS_GSLOC); const float* dec = (const float*)(c.ws + WS_GDEC);
    for (int ch = c.bx * NTHR + c.tid; ch < BATCH * 4 * 4096; ch += c.G * NTHR) {
        const int ed = ch & 4095, bh = ch >> 12, b = bh >> 2, h = bh & 3, d = ed & 63;
        float st = 0.f;
#pragma unroll 1
        for (int n0 = 0; n0 < 64; n0 += 32) {
            float sv[32], dv[32];
#pragma unroll
            for (int n = 0; n < 32; ++n) { const int task = (b * 64 + n0 + n) * 4 + h; dv[n] = dec[(size_t)task * 64 + d]; sv[n] = Sl[(size_t)task * 4096 + ed]; }
#pragma unroll
            for (int n = 0; n < 32; ++n) { const int task = (b * 64 + n0 + n) * 4 + h; Sl[(size_t)task * 4096 + ed] = st; st = st * dv[n] + sv[n]; }
        }
    }
}
__device__ __forceinline__ void s5_1_unit(const Args& a, const Ctx& c0, int l, int unit) {
    RELAUNDER_CTX(c0);
    const int g = unit & 15, nb = unit >> 4;
    const bf16* P = (const bf16*)(c.ws + WS_PROJ);
    const bf16* We = (const bf16*)(c.ws + WS_WNM + (size_t)l * WN_LAYER + WN_S5E) + (size_t)g * 128 * 256;
    LAS bf16* WB = (LAS bf16*)c.lds;
    __syncthreads();
#pragma unroll
    for (int i = 0; i < 8; ++i) { const int idx = c.tid + NTHR * i, q = idx >> 5, kk = (idx & 31) * 8; *(LAS u32x4*)(WB + q * 264 + kk) = *(const u32x4*)(We + (size_t)q * 256 + kk); }
    __syncthreads();
    const int fr = c.lane & 15, fq = c.lane >> 4;
    const int n = nb * 128 + c.wave * 16 + fr;
    bf16x8 af[8];
#pragma unroll
    for (int ks = 0; ks < 8; ++ks) { const int s = 2 * ks + (fq >> 1), c0 = 8 * (fq & 1); af[ks] = *(const bf16x8*)(P + POFF(16 * n + s, C_SU) + 16 * g + c0); }
    float* XE = (float*)(c.ws + WS_XE);
#pragma unroll
    for (int qb = 0; qb < 8; ++qb) { f32x4 acc = {0.f, 0.f, 0.f, 0.f};
#pragma unroll
        for (int ks = 0; ks < 8; ++ks) { const bf16x8 bv = *(const LAS bf16x8*)(WB + (16 * qb + fr) * 264 + 32 * ks + 8 * fq); acc = __builtin_amdgcn_mfma_f32_16x16x32_bf16(af[ks], bv, acc, 0, 0, 0); }
#pragma unroll
        for (int r = 0; r < 4; ++r) XE[((size_t)(nb * 128 + c.wave * 16 + 4 * fq + r) * 16 + g) * 128 + 16 * qb + fr] = acc[r]; }
}
__device__ __forceinline__ void s5_2_phase(const Args& a, const Ctx& c, int l) {
    const float* XE = (const float*)(c.ws + WS_XE); bf16* XP = (bf16*)(c.ws + WS_XP);
    const f32x2* LL = (const f32x2*)(c.ws + WS_LAML) + l * 1024;
    LAS f32x2* CE = (LAS f32x2*)(c.lds);
    for (int bg = c.bx; bg < BATCH * 16; bg += c.G) {
        const int b = bg >> 4, g = bg & 15, p = c.lane; const f32x2 lm = LL[g * 64 + p];
        const size_t base0 = ((size_t)(b * 256 + 32 * c.wave) * 16 + g) * 128;
        float er[32], ei[32];
#pragma unroll
        for (int i = 0; i < 32; ++i) { er[i] = XE[base0 + (size_t)i * 2048 + p]; ei[i] = XE[base0 + (size_t)i * 2048 + 64 + p]; }
        float xr = 0.f, xi = 0.f;
#pragma unroll
        for (int i = 0; i < 32; ++i) { const float nr = lm.x * xr - lm.y * xi + er[i], ni = lm.x * xi + lm.y * xr + ei[i]; xr = nr; xi = ni; }
        CE[c.wave * 64 + p] = (f32x2){xr, xi};
        float pr = lm.x, pi = lm.y;
#pragma unroll
        for (int q = 0; q < 5; ++q) { const float nr = pr * pr - pi * pi, ni = 2.f * pr * pi; pr = nr; pi = ni; }
        __syncthreads();
        float sr = 0.f, si = 0.f;
        for (int u = 0; u < c.wave; ++u) { const f32x2 e = CE[u * 64 + p]; const float nr = pr * sr - pi * si + e.x, ni = pr * si + pi * sr + e.y; sr = nr; si = ni; }
        xr = sr; xi = si;
#pragma unroll
        for (int i = 0; i < 32; ++i) { XP[base0 + (size_t)i * 2048 + p] = (bf16)f2bf(xr); XP[base0 + (size_t)i * 2048 + 64 + p] = (bf16)f2bf(xi);
            const float nr = lm.x * xr - lm.y * xi + er[i], ni = lm.x * xi + lm.y * xr + ei[i]; xr = nr; xi = ni; }
        __syncthreads();
    }
}
__device__ __forceinline__ float gelu_tanh(float x) { const float u = 0.7978845608028654f * (x + 0.044715f * x * x * x); const float e = __expf(2.f * u); const float th = 1.f - 2.f * __builtin_amdgcn_rcpf(e + 1.f); return 0.5f * x * (1.f + th); }
__device__ __forceinline__ void s5_3_unit(const Args& a, const Ctx& c0, int l, int unit) {
    RELAUNDER_CTX(c0);
    const int g = unit & 15, nb = (unit >> 4) & 7, nh = unit >> 7;
    const bf16* P = (const bf16*)(c.ws + WS_PROJ); const bf16* XP = (const bf16*)(c.ws + WS_XP); bf16* YP = (bf16*)(c.ws + WS_YPRE);
    const bf16* Bc = (const bf16*)(c.ws + WS_WNM + (size_t)l * WN_LAYER + WN_S5B) + ((size_t)g * 256 + 128 * nh) * 384;
    LAS bf16* BB = (LAS bf16*)c.lds;
    __syncthreads();
#pragma unroll
    for (int i = 0; i < 12; ++i) { const int idx = c.tid + NTHR * i, q = idx / 48, kk = (idx % 48) * 8; *(LAS u32x4*)(BB + q * 392 + kk) = *(const u32x4*)(Bc + (size_t)q * 384 + kk); }
    __syncthreads();
    const int fr = c.lane & 15, fq = c.lane >> 4;
    f32x4 acc[2][8];
#pragma unroll
    for (int mi = 0; mi < 2; ++mi)
#pragma unroll
        for (int cb = 0; cb < 8; ++cb) acc[mi][cb] = (f32x4){0.f, 0.f, 0.f, 0.f};
    const int nrow0 = nb * 256 + c.wave * 32;
#pragma unroll
    for (int ks = 0; ks < 12; ++ks) {
        bf16x8 af[2];
#pragma unroll
        for (int mi = 0; mi < 2; ++mi) { const int n = nrow0 + 16 * mi + fr;
            if (ks < 8) { const int s = 2 * ks + (fq >> 1), c0 = 8 * (fq & 1); af[mi] = *(const bf16x8*)(P + POFF(16 * n + s, C_SU) + 16 * g + c0); }
            else af[mi] = *(const bf16x8*)(XP + ((size_t)n * 16 + g) * 128 + 32 * (ks - 8) + 8 * fq); }
#pragma unroll
        for (int cb = 0; cb < 8; ++cb) { const bf16x8 bv = *(const LAS bf16x8*)(BB + (16 * cb + fr) * 392 + 32 * ks + 8 * fq);
#pragma unroll
            for (int mi = 0; mi < 2; ++mi) acc[mi][cb] = __builtin_amdgcn_mfma_f32_16x16x32_bf16(af[mi], bv, acc[mi][cb], 0, 0, 0); }
    }
    const float dsk = a.in[I_S5_D + c.z][l * 256 + 16 * g + fr];
    unsigned uv[2][8][4];
#pragma unroll
    for (int mi = 0; mi < 2; ++mi)
#pragma unroll
        for (int cb = 0; cb < 8; ++cb)
#pragma unroll
            for (int r = 0; r < 4; ++r) { const int n = nrow0 + 16 * mi + 4 * fq + r; const size_t tok = (size_t)16 * n + 8 * nh + cb; uv[mi][cb][r] = P[POFF(tok, C_SU) + 16 * g + fr]; }
    __builtin_amdgcn_sched_barrier(0);
#pragma unroll
    for (int mi = 0; mi < 2; ++mi)
#pragma unroll
        for (int cb = 0; cb < 8; ++cb)
#pragma unroll
            for (int r = 0; r < 4; ++r) { const int n = nrow0 + 16 * mi + 4 * fq + r; const size_t tok = (size_t)16 * n + 8 * nh + cb;
                const float u = bf2f(uv[mi][cb][r]); const float y = acc[mi][cb][r] + dsk * u;
                YP[tok * 256 + 16 * g + fr] = (bf16)f2bf(gelu_tanh(y)); }
}

constexpr int DS_CAP = 2048, DS_FIRST = 1024;
constexpr int DS_BUF = 0;
constexpr int DS_HIST = 131072;
constexpr int DS_CNT = DS_HIST + 8192;
__device__ __forceinline__ float fmax_f(float a, float b) { return __builtin_amdgcn_fmed3f(a, b, 3.3e38f); }
__device__ __forceinline__ float relu_f(float a) { return __builtin_amdgcn_fmed3f(a, 0.f, 3.3e38f); }
__device__ __forceinline__ unsigned okey(float f) { const unsigned u = __float_as_uint(f); return (u & 0x80000000u) ? ~u : (u | 0x80000000u); }

__device__ __forceinline__ unsigned select_top(LAS unsigned* buf, int n, int keep, LAS unsigned* hist, int lane) {
    unsigned x[32];
#pragma unroll
    for (int i = 0; i < 32; ++i) x[i] = (64 * i + lane < n) ? buf[64 * i + lane] : 0u;
    unsigned prefix = 0u, mask = 0u; int kth = keep;
#pragma unroll
    for (int pass = 0; pass < 4; ++pass) {
        const int shift = 24 - 8 * pass;
        hist[4 * lane] = 0u; hist[4 * lane + 1] = 0u; hist[4 * lane + 2] = 0u; hist[4 * lane + 3] = 0u;
        asm volatile("s_waitcnt lgkmcnt(0)" ::: "memory");
#pragma unroll
        for (int i = 0; i < 32; ++i) if (64 * i < n) { if (x[i] != 0u && (x[i] & mask) == prefix) __hip_atomic_fetch_add(hist + ((x[i] >> shift) & 255u), 1u, __ATOMIC_RELAXED, __HIP_MEMORY_SCOPE_WORKGROUP); }
        asm volatile("s_waitcnt lgkmcnt(0)" ::: "memory");
        u32x4 hv; hv.x = hist[252 - 4 * lane]; hv.y = hist[253 - 4 * lane]; hv.z = hist[254 - 4 * lane]; hv.w = hist[255 - 4 * lane];
        asm volatile("s_waitcnt lgkmcnt(0)" ::: "memory");
        const unsigned s = hv.x + hv.y + hv.z + hv.w;
        unsigned incl = s;
#pragma unroll
        for (int o = 1; o < 64; o <<= 1) { const unsigned t = __shfl_up(incl, o); if (lane >= o) incl += t; }
        const unsigned long long bal = __ballot(incl >= (unsigned)kth);
        const int L = __ffsll((long long)bal) - 1;
        unsigned cexc = incl - s, digit, above;
        if (cexc + hv.w >= (unsigned)kth) { digit = 255u - 4u * lane; above = cexc; }
        else { cexc += hv.w; if (cexc + hv.z >= (unsigned)kth) { digit = 254u - 4u * lane; above = cexc; }
            else { cexc += hv.z; if (cexc + hv.y >= (unsigned)kth) { digit = 253u - 4u * lane; above = cexc; } else { cexc += hv.y; digit = 252u - 4u * lane; above = cexc; } } }
        digit = __shfl(digit, L); above = __shfl(above, L);
        prefix |= digit << shift; mask |= 255u << shift; kth -= (int)above;
    }
    const unsigned thr = prefix;
    int base = 0;
#pragma unroll
    for (int i = 0; i < 32; ++i) if (64 * i < n) {
        const bool k = x[i] >= thr && x[i] != 0u; const unsigned long long m = __ballot(k);
        const int pos = base + (int)__builtin_amdgcn_mbcnt_hi((unsigned)(m >> 32), __builtin_amdgcn_mbcnt_lo((unsigned)m, 0u));
        if (k) buf[pos] = x[i];
        base += __popcll(m);
    }
    return thr;
}

__device__ __forceinline__ unsigned select_top2(LAS unsigned* buf, int n, int keep, int lane) {
    LAS unsigned* hist = buf + 1024;
    unsigned x[16];
#pragma unroll
    for (int i = 0; i < 16; ++i) x[i] = (64 * i + lane < n) ? buf[64 * i + lane] : 0u;
    unsigned av = ~0u, ov = 0u;
#pragma unroll
    for (int i = 0; i < 16; ++i) if (x[i] != 0u) { av &= x[i]; ov |= x[i]; }
#pragma unroll
    for (int o = 1; o < 64; o <<= 1) { av &= (unsigned)__shfl_xor((int)av, o); ov |= (unsigned)__shfl_xor((int)ov, o); }
    const unsigned diff = (av ^ ov) >> 12;
    const int hi = diff ? 32 - __clz(diff) : 0;
    int hb = hi + 12;
    unsigned mask = (hb >= 32) ? 0u : ~((1u << hb) - 1u), prefix = av & mask; int kth = keep;
    asm volatile("s_waitcnt lgkmcnt(0)" ::: "memory");
#pragma unroll 1
    while (hb > 0) {
        int w = (hb > 12) ? hb - 12 : hb; if (w > 10) w -= 10;
        const int shift = hb - w; const unsigned dm = (1u << w) - 1u;
#pragma unroll
        for (int j = 0; j < 4; ++j) { unsigned z0_ = 0u; asm volatile("" : "+v"(z0_)); *(LAS u32x4*)(hist + 16 * lane + 4 * j) = (u32x4){z0_, z0_, z0_, z0_}; }
        asm volatile("s_waitcnt lgkmcnt(0)" ::: "memory");
#pragma unroll
        for (int i = 0; i < 16; ++i) if (64 * i < n) { if (x[i] != 0u && (x[i] & mask) == prefix) __hip_atomic_fetch_add(hist + ((x[i] >> shift) & dm), 1u, __ATOMIC_RELAXED, __HIP_MEMORY_SCOPE_WORKGROUP); }
        asm volatile("s_waitcnt lgkmcnt(0)" ::: "memory");
        unsigned b[16];
#pragma unroll
        for (int j = 0; j < 4; ++j) { const u32x4 hv = *(const LAS u32x4*)(hist + 1008 - 16 * lane + 4 * j); b[4 * j] = hv.x; b[4 * j + 1] = hv.y; b[4 * j + 2] = hv.z; b[4 * j + 3] = hv.w; }
        asm volatile("s_waitcnt lgkmcnt(0)" ::: "memory");
        unsigned s = 0u;
#pragma unroll
        for (int j = 0; j < 16; ++j) s += b[j];
        unsigned incl = s;
#pragma unroll
        for (int o = 1; o < 64; o <<= 1) { const unsigned t = __shfl_up(incl, o); if (lane >= o) incl += t; }
        const unsigned long long bal = __ballot(incl >= (unsigned)kth);
        const int L = __ffsll((long long)bal) - 1;
        unsigned cexc = incl - s, digit = 0u, above = 0u, m = 0u; bool found = false;
#pragma unroll
        for (int j = 15; j >= 0; --j) { if (!found) { if (cexc + b[j] >= (unsigned)kth) { digit = (unsigned)(1008 - 16 * lane + j); above = cexc; m = b[j]; found = true; } else cexc += b[j]; } }
        digit = __shfl(digit, L); above = __shfl(above, L); m = __shfl(m, L);
        prefix |= digit << shift; mask |= dm << shift; kth -= (int)above; hb = shift;
        if ((unsigned)kth == m) break;
    }
    const unsigned thr = prefix;
    int base = 0;
#pragma unroll
    for (int i = 0; i < 16; ++i) if (64 * i < n) {
        const bool k = x[i] >= thr && x[i] != 0u; const unsigned long long mm = __ballot(k);
        const int pos = base + (int)__builtin_amdgcn_mbcnt_hi((unsigned)(mm >> 32), __builtin_amdgcn_mbcnt_lo((unsigned)mm, 0u));
        if (k) buf[pos] = x[i];
        base += __popcll(mm);
    }
    asm volatile("s_waitcnt lgkmcnt(0)" ::: "memory");
    return thr;
}
#ifndef DPP_U
#define DPP_U(v, old, ctrl) ((unsigned)__builtin_amdgcn_update_dpp((int)(old), (int)(v), (ctrl), 0xF, 0xF, false))
#endif
__device__ __forceinline__ unsigned wave_min_u(unsigned v) {
    unsigned t;
    t = DPP_U(v, v, 0x128); v = v < t ? v : t; t = DPP_U(v, v, 0x124); v = v < t ? v : t; t = DPP_U(v, v, 0x122); v = v < t ? v : t; t = DPP_U(v, v, 0x121); v = v < t ? v : t;
    const unsigned r0 = (unsigned)__builtin_amdgcn_readlane((int)v, 0), r1 = (unsigned)__builtin_amdgcn_readlane((int)v, 16), r2 = (unsigned)__builtin_amdgcn_readlane((int)v, 32), r3 = (unsigned)__builtin_amdgcn_readlane((int)v, 48);
    const unsigned a = r0 < r1 ? r0 : r1, b = r2 < r3 ? r2 : r3; return a < b ? a : b;
}
__device__ __forceinline__ unsigned wave_max_u(unsigned v) {
    unsigned t;
    t = DPP_U(v, v, 0x128); v = v > t ? v : t; t = DPP_U(v, v, 0x124); v = v > t ? v : t; t = DPP_U(v, v, 0x122); v = v > t ? v : t; t = DPP_U(v, v, 0x121); v = v > t ? v : t;
    const unsigned r0 = (unsigned)__builtin_amdgcn_readlane((int)v, 0), r1 = (unsigned)__builtin_amdgcn_readlane((int)v, 16), r2 = (unsigned)__builtin_amdgcn_readlane((int)v, 32), r3 = (unsigned)__builtin_amdgcn_readlane((int)v, 48);
    const unsigned a = r0 > r1 ? r0 : r1, b = r2 > r3 ? r2 : r3; return a > b ? a : b;
}
__device__ __forceinline__ unsigned wave_incl_scan_u(unsigned v, int lane) {
    v += DPP_U(v, 0u, 0x111); v += DPP_U(v, 0u, 0x112); v += DPP_U(v, 0u, 0x114); v += DPP_U(v, 0u, 0x118);
    const unsigned t0 = (unsigned)__builtin_amdgcn_readlane((int)v, 15), t1 = (unsigned)__builtin_amdgcn_readlane((int)v, 31), t2 = (unsigned)__builtin_amdgcn_readlane((int)v, 47);
    const unsigned add = lane >= 48 ? t0 + t1 + t2 : (lane >= 32 ? t0 + t1 : (lane >= 16 ? t0 : 0u));
    return v + add;
}
__device__ __forceinline__ float key2f(unsigned p) { const unsigned u = p & 0xFFFFF000u; return __uint_as_float((u & 0x80000000u) ? (u ^ 0x80000000u) : ~u); }
__device__ __forceinline__ unsigned select_lin(LAS unsigned* buf, int n, int keep, int lane, const bool dry = false) {
    LAS unsigned* hist = buf + 1024;
    unsigned x[16];
#pragma unroll
    for (int i = 0; i < 16; ++i) x[i] = (64 * i + lane < n) ? buf[64 * i + lane] : 0u;
    unsigned kmin = ~0u, kmax = 0u;
#pragma unroll
    for (int i = 0; i < 16; ++i) if (x[i] != 0u) { kmin = kmin < x[i] ? kmin : x[i]; kmax = kmax > x[i] ? kmax : x[i]; }
    kmin = wave_min_u(kmin); kmax = wave_max_u(kmax);
    const float lo = key2f(kmin), hv_ = key2f(kmax);
    const float scale = (hv_ > lo) ? 1023.f / (hv_ - lo) : 0.f;
    int bk[16];
#pragma unroll
    for (int i = 0; i < 16; ++i) { int q = (int)((key2f(x[i]) - lo) * scale); q = q > 1023 ? 1023 : q; q = q < 0 ? 0 : q; bk[i] = (x[i] != 0u) ? q : -1; }
#pragma unroll
    for (int j = 0; j < 4; ++j) { unsigned z0_ = 0u; asm volatile("" : "+v"(z0_)); *(LAS u32x4*)(hist + 16 * lane + 4 * j) = (u32x4){z0_, z0_, z0_, z0_}; }
    asm volatile("s_waitcnt lgkmcnt(0)" ::: "memory");
#pragma unroll
    for (int i = 0; i < 16; ++i) if (64 * i < n) { if (bk[i] >= 0) __hip_atomic_fetch_add(hist + bk[i], 1u, __ATOMIC_RELAXED, __HIP_MEMORY_SCOPE_WORKGROUP); }
    asm volatile("s_waitcnt lgkmcnt(0)" ::: "memory");
    unsigned b[16];
#pragma unroll
    for (int j = 0; j < 4; ++j) { const u32x4 hv = *(const LAS u32x4*)(hist + 1008 - 16 * lane + 4 * j); b[4 * j] = hv.x; b[4 * j + 1] = hv.y; b[4 * j + 2] = hv.z; b[4 * j + 3] = hv.w; }
    asm volatile("s_waitcnt lgkmcnt(0)" ::: "memory");
    unsigned s = 0u;
#pragma unroll
    for (int j = 0; j < 16; ++j) s += b[j];
    const unsigned incl = wave_incl_scan_u(s, lane);
    const unsigned long long bal = __ballot(incl >= (unsigned)keep);
    const int L = __ffsll((long long)bal) - 1;
    unsigned cexc = incl - s, digit = 0u, above = 0u, m = 0u; bool found = false;
#pragma unroll
    for (int j = 15; j >= 0; --j) { if (!found) { if (cexc + b[j] >= (unsigned)keep) { digit = (unsigned)(1008 - 16 * lane + j); above = cexc; m = b[j]; found = true; } else cexc += b[j]; } }
    digit = (unsigned)__builtin_amdgcn_readlane((int)digit, L); above = (unsigned)__builtin_amdgcn_readlane((int)above, L); m = (unsigned)__builtin_amdgcn_readlane((int)m, L);
    const int bstar = (int)digit, kth2 = keep - (int)above, mt = (int)m;
    int base = 0;
#pragma unroll
    for (int i = 0; i < 16; ++i) if (64 * i < n) {
        const bool td = bk[i] == bstar; const unsigned long long mm = __ballot(td);
        const int pos = base + (int)__builtin_amdgcn_mbcnt_hi((unsigned)(mm >> 32), __builtin_amdgcn_mbcnt_lo((unsigned)mm, 0u));
        if (td) hist[pos] = x[i];
        base += __popcll(mm);
    }
    asm volatile("s_waitcnt lgkmcnt(0)" ::: "memory");
    unsigned cnt[16];
#pragma unroll
    for (int i = 0; i < 16; ++i) cnt[i] = 0u;
#pragma unroll 1
    for (int j = 0; j < mt; ++j) { const unsigned t = hist[j];
#pragma unroll
        for (int i = 0; i < 16; ++i) cnt[i] += (t > x[i]) ? 1u : 0u; }
    asm volatile("s_waitcnt lgkmcnt(0)" ::: "memory");
    bool kp[16];
#pragma unroll
    for (int i = 0; i < 16; ++i) { kp[i] = bk[i] > bstar || (bk[i] == bstar && (int)cnt[i] < kth2); if (bk[i] == bstar && (int)cnt[i] == kth2 - 1) hist[1023] = x[i]; }
    asm volatile("s_waitcnt lgkmcnt(0)" ::: "memory");
    const unsigned thr = hist[1023];
    base = 0;
#pragma unroll
    for (int i = 0; i < 16; ++i) if (64 * i < n) {
        const unsigned long long mm = __ballot(kp[i]);
        const int pos = base + (int)__builtin_amdgcn_mbcnt_hi((unsigned)(mm >> 32), __builtin_amdgcn_mbcnt_lo((unsigned)mm, 0u));
        if (kp[i]) { if (!dry) buf[pos] = x[i]; else hist[pos & 1023] = x[i]; }
        base += __popcll(mm);
    }
    asm volatile("s_waitcnt lgkmcnt(0)" ::: "memory");
    return thr;
}
__device__ __forceinline__ unsigned select_lin_loose(LAS unsigned* buf, int n, int keep, int lane, int& kept, const bool dry = false) {
    LAS unsigned* hist = buf + 1024;
    unsigned x[16];
#pragma unroll
    for (int i = 0; i < 16; ++i) x[i] = (64 * i + lane < n) ? buf[64 * i + lane] : 0u;
    unsigned kmin = ~0u, kmax = 0u;
#pragma unroll
    for (int i = 0; i < 16; ++i) if (x[i] != 0u) { kmin = kmin < x[i] ? kmin : x[i]; kmax = kmax > x[i] ? kmax : x[i]; }
    kmin = wave_min_u(kmin); kmax = wave_max_u(kmax);
    const float lo = key2f(kmin), hv_ = key2f(kmax);
    const float scale = (hv_ > lo) ? 1023.f / (hv_ - lo) : 0.f;
    int bk[16];
#pragma unroll
    for (int i = 0; i < 16; ++i) { int q = (int)((key2f(x[i]) - lo) * scale); q = q > 1023 ? 1023 : q; q = q < 0 ? 0 : q; bk[i] = (x[i] != 0u) ? q : -1; }
#pragma unroll
    for (int j = 0; j < 4; ++j) { unsigned z0_ = 0u; asm volatile("" : "+v"(z0_)); *(LAS u32x4*)(hist + 16 * lane + 4 * j) = (u32x4){z0_, z0_, z0_, z0_}; }
    asm volatile("s_waitcnt lgkmcnt(0)" ::: "memory");
#pragma unroll
    for (int i = 0; i < 16; ++i) if (64 * i < n) { if (bk[i] >= 0) __hip_atomic_fetch_add(hist + bk[i], 1u, __ATOMIC_RELAXED, __HIP_MEMORY_SCOPE_WORKGROUP); }
    asm volatile("s_waitcnt lgkmcnt(0)" ::: "memory");
    unsigned b[16];
#pragma unroll
    for (int j = 0; j < 4; ++j) { const u32x4 hv = *(const LAS u32x4*)(hist + 1008 - 16 * lane + 4 * j); b[4 * j] = hv.x; b[4 * j + 1] = hv.y; b[4 * j + 2] = hv.z; b[4 * j + 3] = hv.w; }
    asm volatile("s_waitcnt lgkmcnt(0)" ::: "memory");
    unsigned s = 0u;
#pragma unroll
    for (int j = 0; j < 16; ++j) s += b[j];
    const unsigned incl = wave_incl_scan_u(s, lane);
    const unsigned long long bal = __ballot(incl >= (unsigned)keep);
    const int L = __ffsll((long long)bal) - 1;
    unsigned cexc = incl - s, digit = 0u, above = 0u, m = 0u; bool found = false;
#pragma unroll
    for (int j = 15; j >= 0; --j) { if (!found) { if (cexc + b[j] >= (unsigned)keep) { digit = (unsigned)(1008 - 16 * lane + j); above = cexc; m = b[j]; found = true; } else cexc += b[j]; } }
    digit = (unsigned)__builtin_amdgcn_readlane((int)digit, L); above = (unsigned)__builtin_amdgcn_readlane((int)above, L); m = (unsigned)__builtin_amdgcn_readlane((int)m, L);
    const int bstar = (int)digit;
    kept = (int)(above + m);
    unsigned kminv = ~0u; int base = 0;
#pragma unroll
    for (int i = 0; i < 16; ++i) if (64 * i < n) {
        const bool kp = bk[i] >= bstar; const unsigned long long mm = __ballot(kp);
        const int pos = base + (int)__builtin_amdgcn_mbcnt_hi((unsigned)(mm >> 32), __builtin_amdgcn_mbcnt_lo((unsigned)mm, 0u));
        if (kp) { if (!dry) buf[pos] = x[i]; else hist[pos & 1023] = x[i]; kminv = kminv < x[i] ? kminv : x[i]; }
        base += __popcll(mm);
    }
    asm volatile("s_waitcnt lgkmcnt(0)" ::: "memory");
    return wave_min_u(kminv) - 1u;
}
__device__ __forceinline__ unsigned select_any(LAS unsigned* buf, int n, int keep, LAS unsigned* hist, int lane) {
    return (n <= 1024) ? select_lin(buf, n, keep, lane) : select_top(buf, n, keep, hist, lane);
}

struct DsaPF { bf16x8 qf[8]; bf16x8 ql; u32x4 w; bf16x8 kfa[4]; };
__device__ __forceinline__ void dsa_prefetch(const Ctx& c, int b, int qt, DsaPF& pf) {
    const bf16* P = (const bf16*)(c.ws + WS_PROJ);
    const int t0 = qt * 16, nkb = qt + 1, fr = c.lane & 15, fq = c.lane >> 4; const size_t tokb = (size_t)b * SEQ;
    const int nkbA = nkb < 64 ? nkb : 64;
#pragma unroll
    for (int h = 0; h < 8; ++h) pf.qf[h] = *(const bf16x8*)(P + POFF(tokb + t0 + fr, C_IQ) + 32 * h + 8 * fq);
    pf.ql = *(const bf16x8*)(P + POFF(tokb + t0 + fr, C_IL) + 8 * fq);
    pf.w = *(const u32x4*)(P + POFF(tokb + t0 + fr, C_IW));
#pragma unroll
    for (int u = 0; u < 4; ++u) { const int kb = c.wave + 8 * u; pf.kfa[u] = *(const bf16x8*)(P + POFF(tokb + (kb < nkbA ? kb : 0) * 16 + fr, C_IK) + 8 * fq); }
}
template <int DO_ATT>
__device__ __forceinline__ void dsa_tile(const Args& a, const Ctx& c0, int b, int qt, int nb_, int nqt, DsaPF& pf, unsigned* qctr = nullptr, LAS int* nxslot = nullptr) {
    RELAUNDER_CTX(c0);
    int popped = 0;
    if (qctr && c.tid == 0) popped = (int)__hip_atomic_fetch_add(qctr, 1u, __ATOMIC_RELAXED, __HIP_MEMORY_SCOPE_AGENT);
    const bf16* P = (const bf16*)(c.ws + WS_PROJ); bf16* HY = (bf16*)(c.ws + WS_HY);
    LAS unsigned* BUF = (LAS unsigned*)(c.lds + DS_BUF); LAS unsigned* HIST = (LAS unsigned*)(c.lds + DS_HIST) + c.wave * 256;
    LAS int* CNT = (LAS int*)(c.lds + DS_CNT); LAS unsigned* THR = (LAS unsigned*)(c.lds + DS_CNT + 64);
    const int t0 = qt * 16, nkb = qt + 1, fr = c.lane & 15, fq = c.lane >> 4;
    const size_t tokb = (size_t)b * SEQ;
    lds_barrier();
    bf16x8 qf[8];
#pragma unroll
    for (int h = 0; h < 8; ++h) qf[h] = pf.qf[h];
    const bf16x8 ql = pf.ql;
    float sg[8];
    { const u32x4 w = pf.w;
      sg[0] = bflo(w.x); sg[1] = bfhi(w.x); sg[2] = bflo(w.y); sg[3] = bfhi(w.y); sg[4] = bflo(w.z); sg[5] = bfhi(w.z); sg[6] = bflo(w.w); sg[7] = bfhi(w.w); }
    const int tq = t0 + fr;
    if (c.tid < 16) { const int t = t0 + c.tid; CNT[c.tid] = (t + 1 < DS_FIRST) ? t + 1 : DS_FIRST; THR[c.tid] = 0u; }
#define DSA_LOADK(kb) (*(const bf16x8*)(P + POFF(tokb + (kb) * 16 + fr, C_IK) + 8 * fq))
#define DSA_COMPUTE(kf, kb, pk) do { \
        f32x4 sc = __builtin_amdgcn_mfma_f32_16x16x32_bf16(kf, ql, (f32x4){0.f, 0.f, 0.f, 0.f}, 0, 0, 0); \
        _Pragma("unroll") for (int h = 0; h < 8; ++h) { const f32x4 d = __builtin_amdgcn_mfma_f32_16x16x32_bf16(kf, qf[h], (f32x4){0.f, 0.f, 0.f, 0.f}, 0, 0, 0); \
            sc.x = __builtin_fmaf(sg[h], __builtin_fabsf(d.x), sc.x); sc.y = __builtin_fmaf(sg[h], __builtin_fabsf(d.y), sc.y); sc.z = __builtin_fmaf(sg[h], __builtin_fabsf(d.z), sc.z); sc.w = __builtin_fmaf(sg[h], __builtin_fabsf(d.w), sc.w); } \
        _Pragma("unroll") for (int r = 0; r < 4; ++r) { const int s = (kb) * 16 + 4 * fq + r; pk[r] = (s <= tq) ? ((okey(sc[r] + 0.f) & 0xFFFFF000u) | (unsigned)(4095 - s)) : 0u; } } while (0)
    const int nkbA = nkb < DS_FIRST / 16 ? nkb : DS_FIRST / 16;
    {
        bf16x8 kfa[4];
#ifdef PROBE_SC2
#pragma unroll 1
        for (int rep_ = 0; rep_ < 2; ++rep_) {
#endif
#pragma unroll
        for (int u = 0; u < 4; ++u) kfa[u] = pf.kfa[u];
#pragma unroll 1
        for (int kb0 = c.wave; kb0 < nkbA; kb0 += 4 * NWAVES) {
            bf16x8 kfn[4];
#pragma unroll
            for (int u = 0; u < 4; ++u) { const int kb = kb0 + 4 * NWAVES + 8 * u; kfn[u] = DSA_LOADK(kb < nkb ? kb : 0); }
#pragma unroll
            for (int u = 0; u < 4; ++u) { const int kb = kb0 + 8 * u; if (kb < nkbA && DO_ATT != 3) { unsigned pk[4]; DSA_COMPUTE(kfa[u], kb, pk);
                *(LAS u32x4*)(BUF + fr * DS_CAP + kb * 16 + 4 * fq) = (u32x4){pk[0], pk[1], pk[2], pk[3]}; }
                __builtin_amdgcn_sched_barrier(0); }
#pragma unroll
            for (int u = 0; u < 4; ++u) kfa[u] = kfn[u];
        }
#ifdef PROBE_SC2
        asm volatile("s_waitcnt lgkmcnt(0)" ::: "memory");
        }
#endif
    if (qctr && c.tid == 0) *nxslot = popped;
    lds_barrier();
#ifndef DSA_NOSEL
    if (nkb > DS_FIRST / 16) {
#pragma unroll 1
        for (int q = 0; q < 2; ++q) { const int r = c.wave + 8 * q; int kept;
#ifdef PROBE_LOOSE2
            { int k2; const unsigned t2 = select_lin_loose(BUF + r * DS_CAP, DS_FIRST, 256, c.lane, k2, true); asm volatile("" :: "v"(t2), "v"(k2)); asm volatile("s_waitcnt lgkmcnt(0)" ::: "memory"); }
#endif
            const unsigned th = select_lin_loose(BUF + r * DS_CAP, DS_FIRST, 256, c.lane, kept); if (c.lane == 0) { CNT[r] = kept; THR[r] = th; } }
        lds_barrier();
#ifdef PROBE_SB2
        {
            bf16x8 kfd[4];
#pragma unroll
            for (int i = 0; i < 4; ++i) { const int kb = DS_FIRST / 16 + c.wave + 8 * i; kfd[i] = DSA_LOADK(kb < nkb ? kb : 0); }
            unsigned dsum = 0u;
#pragma unroll 1
            for (int kb0 = DS_FIRST / 16; kb0 < nkb; kb0 += 32) {
                const unsigned th = THR[fr];
                bf16x8 kfn[4];
#pragma unroll
                for (int i = 0; i < 4; ++i) { const int kb = kb0 + 32 + c.wave + 8 * i; kfn[i] = DSA_LOADK(kb < nkb ? kb : 0); }
#pragma unroll
                for (int i = 0; i < 4; ++i) { const int kb = kb0 + c.wave + 8 * i; if (kb < nkb) { unsigned pk[4]; DSA_COMPUTE(kfd[i], kb, pk);
#pragma unroll
                        for (int r = 0; r < 4; ++r) if (pk[r] > th) dsum += pk[r]; }
                    __builtin_amdgcn_sched_barrier(0); }
#pragma unroll
                for (int i = 0; i < 4; ++i) kfd[i] = kfn[i];
                __syncthreads();
                bool need = false;
#pragma unroll
                for (int r = 0; r < 16; ++r) need = need || (CNT[r] > DS_CAP - 512);
                __syncthreads();
                if (need) dsum += 1u;
            }
            asm volatile("" :: "v"(dsum));
        }
#endif
#ifdef PROBE_SC2
#pragma unroll
        for (int i = 0; i < 4; ++i) { const int kb = DS_FIRST / 16 + c.wave + 8 * i; kfa[i] = DSA_LOADK(kb < nkb ? kb : 0); }
#endif
#pragma unroll 1
        for (int kb0 = DS_FIRST / 16; kb0 < nkb; kb0 += 32) {
            const unsigned th = THR[fr];
            bf16x8 kfn[4];
#pragma unroll
            for (int i = 0; i < 4; ++i) { const int kb = kb0 + 32 + c.wave + 8 * i; kfn[i] = DSA_LOADK(kb < nkb ? kb : 0); }
#pragma unroll
            for (int i = 0; i < 4; ++i) { const int kb = kb0 + c.wave + 8 * i; if (kb < nkb && DO_ATT != 3) { unsigned pk[4]; DSA_COMPUTE(kfa[i], kb, pk);
#pragma unroll
                    for (int r = 0; r < 4; ++r) if (pk[r] > th) { const int pos = __hip_atomic_fetch_add(&CNT[fr], 1, __ATOMIC_RELAXED, __HIP_MEMORY_SCOPE_WORKGROUP); if (pos < DS_CAP) BUF[fr * DS_CAP + pos] = pk[r]; } }
                __builtin_amdgcn_sched_barrier(0); }
#pragma unroll
            for (int i = 0; i < 4; ++i) kfa[i] = kfn[i];
            lds_barrier();
            bool need = false;
#pragma unroll
            for (int r = 0; r < 16; ++r) need = need || (CNT[r] > DS_CAP - 512);
            lds_barrier();
            if (need) {
#pragma unroll 1
                for (int q = 0; q < 2; ++q) { const int r = c.wave + 8 * q; int n = CNT[r]; n = n < DS_CAP ? n : DS_CAP;
                    if (n > 256) { const unsigned th2 = select_any(BUF + r * DS_CAP, n, 256, HIST, c.lane); if (c.lane == 0) { CNT[r] = 256; THR[r] = th2; } } }
                lds_barrier();
            }
        }
    }
#endif
    }
    if (nqt >= 0) dsa_prefetch(c, nb_, nqt, pf);
#pragma unroll 1
    for (int q = 0; q < 2; ++q) {
        const int r = c.wave + 8 * q, t = t0 + r; const size_t tok = tokb + t;
        LAS unsigned* rb = BUF + r * DS_CAP;
        int n = CNT[r]; n = n < DS_CAP ? n : DS_CAP;
#ifdef DSA_NOSEL
        if (n > 256) n = 256;
#else
#ifdef PROBE_FINAL2
        if (n > 256 && n <= 1024) { const unsigned t2 = select_lin(rb, n, 256, c.lane, true); asm volatile("" :: "v"(t2)); asm volatile("s_waitcnt lgkmcnt(0)" ::: "memory"); }
#endif
        if (n > 256) { (void)select_any(rb, n, 256, HIST, c.lane); n = 256; }
#endif
        if (nkb > DS_FIRST / 16) {
#ifdef PROBE_CANON2
#pragma unroll 1
            for (int rep_ = 0; rep_ < 2; ++rep_) {
#endif
            unsigned cv[4]; int cs_[4];
#pragma unroll
            for (int jj = 0; jj < 4; ++jj) { const int i = c.lane + 64 * jj; cv[jj] = (i < n) ? rb[i] : 0u; cs_[jj] = (int)(cv[jj] & 0xFFFu); }
            HIST[2 * c.lane] = 0u; HIST[2 * c.lane + 1] = 0u;
            asm volatile("s_waitcnt lgkmcnt(0)" ::: "memory");
#pragma unroll
            for (int jj = 0; jj < 4; ++jj) if (cv[jj] != 0u) __hip_atomic_fetch_or(HIST + (cs_[jj] >> 5), 1u << (cs_[jj] & 31), __ATOMIC_RELAXED, __HIP_MEMORY_SCOPE_WORKGROUP);
            asm volatile("s_waitcnt lgkmcnt(0)" ::: "memory");
            const unsigned w0 = HIST[2 * c.lane], w1 = HIST[2 * c.lane + 1];
            const unsigned own = (unsigned)(__popc(w0) + __popc(w1));
            const unsigned incl = wave_incl_scan_u(own, c.lane);
            asm volatile("s_waitcnt lgkmcnt(0)" ::: "memory");
            HIST[128 + 2 * c.lane] = incl - own; HIST[128 + 2 * c.lane + 1] = incl - own + (unsigned)__popc(w0);
            asm volatile("s_waitcnt lgkmcnt(0)" ::: "memory");
#pragma unroll
            for (int jj = 0; jj < 4; ++jj) if (cv[jj] != 0u) { const int wi = cs_[jj] >> 5; const unsigned bw = HIST[wi], pre = HIST[128 + wi];
                rb[pre + (unsigned)__popc(bw & ((1u << (cs_[jj] & 31)) - 1u))] = cv[jj]; }
            asm volatile("s_waitcnt lgkmcnt(0)" ::: "memory");
#ifdef PROBE_CANON2
            }
#endif
        }
        if (DO_ATT == 1 || DO_ATT == 2) {
        int ln_ = c.lane; asm volatile("" : "+v"(ln_));
        const int fr = ln_ & 15, fq = ln_ >> 4;
        {
            const unsigned first = rb[0]; u32x4 kv = *(const LAS u32x4*)(rb + 4 * ln_);
            unsigned of0 = 4095u - (first & 0xFFFu); if (DO_ATT == 2) of0 &= 15u;
#pragma unroll
            for (int e = 0; e < 4; ++e) { unsigned o = 4095u - (kv[e] & 0xFFFu); if (DO_ATT == 2) o &= 15u; kv[e] = ((4 * ln_ + e < n) ? o : of0) << 9; }
            asm volatile("s_waitcnt lgkmcnt(0)" ::: "memory");
            *(LAS u32x4*)(rb + 4 * ln_) = kv;
            asm volatile("s_waitcnt lgkmcnt(0)" ::: "memory");
        }
        typedef const __attribute__((address_space(1))) char* gptr_t;
        gptr_t kbase; gptr_t vbase;
        { const unsigned long long ka_ = (unsigned long long)(c.ws + WS_K8 + tokb * 64), va_ = (unsigned long long)(c.ws + WS_V8 + tokb * 64);
          kbase = (gptr_t)(((unsigned long long)(unsigned)__builtin_amdgcn_readfirstlane((int)(ka_ >> 32)) << 32) | (unsigned)__builtin_amdgcn_readfirstlane((int)ka_));
          vbase = (gptr_t)(((unsigned long long)(unsigned)__builtin_amdgcn_readfirstlane((int)(va_ >> 32)) << 32) | (unsigned)__builtin_amdgcn_readfirstlane((int)va_)); }
        long qb[2] = {0l, 0l};
        if (fr < 4) { const bf16x8 q0 = *(const bf16x8*)(P + POFF(tok, C_DQ) + fr * 64 + 16 * fq), q1 = *(const bf16x8*)(P + POFF(tok, C_DQ) + fr * 64 + 16 * fq + 8);
            int w0 = __builtin_amdgcn_cvt_pk_fp8_f32(8.f * bf2f((unsigned short)q0[0]), 8.f * bf2f((unsigned short)q0[1]), 0, false); w0 = __builtin_amdgcn_cvt_pk_fp8_f32(8.f * bf2f((unsigned short)q0[2]), 8.f * bf2f((unsigned short)q0[3]), w0, true);
            int w1 = __builtin_amdgcn_cvt_pk_fp8_f32(8.f * bf2f((unsigned short)q0[4]), 8.f * bf2f((unsigned short)q0[5]), 0, false); w1 = __builtin_amdgcn_cvt_pk_fp8_f32(8.f * bf2f((unsigned short)q0[6]), 8.f * bf2f((unsigned short)q0[7]), w1, true);
            int w2 = __builtin_amdgcn_cvt_pk_fp8_f32(8.f * bf2f((unsigned short)q1[0]), 8.f * bf2f((unsigned short)q1[1]), 0, false); w2 = __builtin_amdgcn_cvt_pk_fp8_f32(8.f * bf2f((unsigned short)q1[2]), 8.f * bf2f((unsigned short)q1[3]), w2, true);
            int w3 = __builtin_amdgcn_cvt_pk_fp8_f32(8.f * bf2f((unsigned short)q1[4]), 8.f * bf2f((unsigned short)q1[5]), 0, false); w3 = __builtin_amdgcn_cvt_pk_fp8_f32(8.f * bf2f((unsigned short)q1[6]), 8.f * bf2f((unsigned short)q1[7]), w3, true);
            qb[0] = (long)(((unsigned long long)(unsigned)w1 << 32) | (unsigned)w0); qb[1] = (long)(((unsigned long long)(unsigned)w3 << 32) | (unsigned)w2); }
        LAS float* LG = (LAS float*)((LAS unsigned char*)rb + 3200);
        LAS bf16* PT = (LAS bf16*)(rb + 256);
        LAS unsigned char* vb = (LAS unsigned char*)rb + 3200;
        const unsigned kvo = 16u * (unsigned)fq, vvo = 16u * (unsigned)(ln_ & 3);
        const int kloc = ln_ >> 2;
#define QK_LOAD(ka_, Q) do { _Pragma("unroll") for (int u = 0; u < 4; ++u) { const unsigned o = (rb[16 * ((Q) * 4 + u) + fr] >> 3) + kvo; ka_[u] = *(const __attribute__((address_space(1))) u32x4*)(kbase + o); } } while (0)
#define QK_MMA(ka_, Q) do { _Pragma("unroll") for (int u = 0; u < 4; ++u) { f32x4 acc = {0.f, 0.f, 0.f, 0.f}; \
                acc = __builtin_amdgcn_mfma_f32_16x16x32_fp8_fp8((long)(((unsigned long long)ka_[u].y << 32) | ka_[u].x), qb[0], acc, 0, 0, 0); \
                acc = __builtin_amdgcn_mfma_f32_16x16x32_fp8_fp8((long)(((unsigned long long)ka_[u].w << 32) | ka_[u].z), qb[1], acc, 0, 0, 0); \
                if (fr < 4) *(LAS f32x4*)(LG + fr * 272 + 16 * ((Q) * 4 + u) + 4 * fq) = acc; } } while (0)
#define PV_GATHER(dst, ks_) do { _Pragma("unroll") for (int j = 0; j < 2; ++j) { const unsigned o = (rb[32 * (ks_) + 16 * j + kloc] >> 3) + vvo; dst[j] = *(const __attribute__((address_space(1))) u32x4*)(vbase + o); } } while (0)
        const int nks = __builtin_amdgcn_readfirstlane((n + 31) >> 5);
#ifdef PROBE_QK2
        { u32x4 ka0[4], ka1[4], ka2[4];
          QK_LOAD(ka0, 0); QK_LOAD(ka1, 1); QK_LOAD(ka2, 2); QK_MMA(ka0, 0); QK_LOAD(ka0, 3); QK_MMA(ka1, 1); QK_MMA(ka2, 2); QK_MMA(ka0, 3);
          asm volatile("s_waitcnt lgkmcnt(0)" ::: "memory"); }
#endif
        u32x4 g[8][2];
        {
            u32x4 ka0[4], ka1[4], ka2[4];
            QK_LOAD(ka0, 0); QK_LOAD(ka1, 1); QK_LOAD(ka2, 2);
            PV_GATHER(g[0], 0); PV_GATHER(g[1], 1); PV_GATHER(g[2], 2); PV_GATHER(g[3], 3);
            QK_MMA(ka0, 0);
            QK_LOAD(ka0, 3);
            QK_MMA(ka1, 1); QK_MMA(ka2, 2);
            PV_GATHER(g[4], 4); PV_GATHER(g[5], 5);
            QK_MMA(ka0, 3);
            PV_GATHER(g[6], 6); PV_GATHER(g[7], 7);
        }
#undef QK_LOAD
#undef QK_MMA
        asm volatile("s_waitcnt lgkmcnt(0)" ::: "memory");
        LAS unsigned char* PT8 = (LAS unsigned char*)(rb + 256);
        float pinv = 0.f;
#ifdef PROBE_SM2
#pragma unroll 1
        for (int rep_ = 0; rep_ < 2; ++rep_)
#endif
        {
            f32x4 lv[4];
#pragma unroll
            for (int j = 0; j < 4; ++j) lv[j] = *(const LAS f32x4*)(LG + fq * 272 + 64 * j + 4 * fr);
            float mx = lv[0][0];
#pragma unroll
            for (int j = 0; j < 4; ++j)
#pragma unroll
                for (int e = 0; e < 4; ++e) mx = fmax_f(mx, lv[j][e]);
            mx = fmaxf(mx, __uint_as_float(DPP_U(__float_as_uint(mx), __float_as_uint(mx), 0x128))); mx = fmaxf(mx, __uint_as_float(DPP_U(__float_as_uint(mx), __float_as_uint(mx), 0x124)));
            mx = fmaxf(mx, __uint_as_float(DPP_U(__float_as_uint(mx), __float_as_uint(mx), 0x122))); mx = fmaxf(mx, __uint_as_float(DPP_U(__float_as_uint(mx), __float_as_uint(mx), 0x121)));
            float ssum = 0.f;
#pragma unroll
            for (int j = 0; j < 4; ++j)
#pragma unroll
                for (int e = 0; e < 4; ++e) { float p = __expf((lv[j][e] - mx) * 0.125f); p = (64 * j + 4 * fr + e < n) ? p : 0.f; lv[j][e] = p; ssum += p; }
            ssum += __uint_as_float(DPP_U(__float_as_uint(ssum), __float_as_uint(ssum), 0x128)); ssum += __uint_as_float(DPP_U(__float_as_uint(ssum), __float_as_uint(ssum), 0x124));
            ssum += __uint_as_float(DPP_U(__float_as_uint(ssum), __float_as_uint(ssum), 0x122)); ssum += __uint_as_float(DPP_U(__float_as_uint(ssum), __float_as_uint(ssum), 0x121));
            pinv = 1.f / (64.f * ssum); asm volatile("" : "+v"(pinv));
#pragma unroll
            for (int j = 0; j < 4; ++j) { int w = __builtin_amdgcn_cvt_pk_fp8_f32(64.f * lv[j][0], 64.f * lv[j][1], 0, false); w = __builtin_amdgcn_cvt_pk_fp8_f32(64.f * lv[j][2], 64.f * lv[j][3], w, true);
                *(LAS int*)(PT8 + fq * 272 + 64 * j + 4 * fr) = w; }
#ifdef PROBE_SM2
            asm volatile("s_waitcnt lgkmcnt(0)" ::: "memory");
#endif
        }
        asm volatile("s_waitcnt lgkmcnt(0)" ::: "memory");
#ifdef PROBE_PV2
#pragma unroll 1
        for (int rep_ = 0; rep_ < 2; ++rep_)
#endif
        {
            f32x4 oacc[4];
#pragma unroll
            for (int nb = 0; nb < 4; ++nb) oacc[nb] = (f32x4){0.f, 0.f, 0.f, 0.f};
            LAS unsigned char* trp = vb + (8 * fq + (fr >> 1)) * 80 + 8 * (fr & 1);
            LAS unsigned char* wrp = vb + kloc * 80 + (ln_ & 3) * 16;
#pragma unroll
            for (int ks = 0; ks < 8; ++ks) {
                if (ks < nks) {
#pragma unroll
                    for (int j = 0; j < 2; ++j) *(LAS u32x4*)(wrp + j * 16 * 80) = g[ks][j];
                    long af = 0l;
                    if (fr < 4) af = *(const LAS long*)(PT8 + fr * 272 + 32 * ks + 8 * fq);
#pragma unroll
                    for (int nb = 0; nb < 4; ++nb) {
                        typedef int i32x2 __attribute__((ext_vector_type(2)));
                        const i32x2 bv = __builtin_amdgcn_ds_read_tr8_b64_v2i32((LAS i32x2*)(trp + nb * 16));
                        oacc[nb] = __builtin_amdgcn_mfma_f32_16x16x32_fp8_fp8(af, (long)(((unsigned long long)(unsigned)bv[1] << 32) | (unsigned)bv[0]), oacc[nb], 0, 0, 0);
                    }
                }
            }
#undef PV_GATHER
            if (fq == 0) {
#pragma unroll
                for (int nb = 0; nb < 4; ++nb)
#pragma unroll
                    for (int h = 0; h < 4; ++h) HY[tok * 1024 + 768 + h * 64 + 16 * nb + fr] = (bf16)f2bf(oacc[nb][h] * __builtin_bit_cast(float, __builtin_amdgcn_readlane(__builtin_bit_cast(int, pinv), 16 * h)));
            }
        }
        }
    }
#undef DSA_COMPUTE
#undef DSA_LOADK
}
template <int DO_ATT>
__device__ __forceinline__ void dsa_phase(const Args& a, const Ctx& c, int l) {
#ifndef DSA_STATIC
    if ((c.G & 7) == 0) {
        const int b = c.bx & 7;
        unsigned* qctr = (unsigned*)(c.ws + WS_CTL) + CW_DSAQ + (l * 8 + b) * 32;
        LAS int* NX = (LAS int*)(c.lds + DS_CNT + 128);
        __syncthreads();
        if (c.tid == 0) { NX[2] = (int)__hip_atomic_fetch_add(qctr, 1u, __ATOMIC_RELAXED, __HIP_MEMORY_SCOPE_AGENT); NX[3] = (int)__hip_atomic_fetch_add(qctr, 1u, __ATOMIC_RELAXED, __HIP_MEMORY_SCOPE_AGENT); }
        __syncthreads();
        int cur = __builtin_amdgcn_readfirstlane(NX[2]), nxt = __builtin_amdgcn_readfirstlane(NX[3]);
        DsaPF pf; if (cur < 256) dsa_prefetch(c, b, 255 - cur, pf);
        for (int k = 0; cur < 256; ++k) {
            dsa_tile<DO_ATT>(a, c, b, 255 - cur, b, nxt < 256 ? 255 - nxt : -1, pf, qctr, NX + (k & 1));
            const int nn = __builtin_amdgcn_readfirstlane(NX[k & 1]);
            cur = nxt; nxt = nn;
        }
    } else
#endif
    if ((c.G & 7) == 0) {
        const int per = c.G >> 3, w = c.bx >> 3, b = c.bx & 7, nr = (256 + per - 1) / per;
        DsaPF pf; { const int idx0 = w; if (idx0 < 256) dsa_prefetch(c, b, 255 - idx0, pf); }
        for (int r = 0; r < nr; ++r) { const int idx = r * per + ((r & 1) ? per - 1 - w : w); const int idn = (r + 1) * per + (((r + 1) & 1) ? per - 1 - w : w);
            if (idx < 256) dsa_tile<DO_ATT>(a, c, b, 255 - idx, b, (r + 1 < nr && idn < 256) ? 255 - idn : -1, pf); }
    } else {
        const int nr = (2048 + c.G - 1) / c.G;
        DsaPF pf; { const int Lx0 = c.bx; if (Lx0 < 2048) dsa_prefetch(c, Lx0 & 7, 255 - (Lx0 >> 3), pf); }
        for (int r = 0; r < nr; ++r) { const int q = (r & 1) ? (c.G - 1 - c.bx) : c.bx; const int Lx = r * c.G + q; const int qn = ((r + 1) & 1) ? (c.G - 1 - c.bx) : c.bx; const int Ln = (r + 1) * c.G + qn;
            if (Lx < 2048) dsa_tile<DO_ATT>(a, c, Lx & 7, 255 - (Lx >> 3), Ln & 7, (r + 1 < nr && Ln < 2048) ? 255 - (Ln >> 3) : -1, pf); }
    }
}

constexpr int XA_K = 0, XA_VT = 69632;
__device__ __forceinline__ void xattn_compute(const Ctx& c, int l, int b, int h, int qb) {
    const bf16* Q = (const bf16*)(c.ws + WS_Q); bf16* O = (bf16*)(c.ws + WS_O);
    LAS bf16* KL = (LAS bf16*)(c.lds + XA_K); LAS bf16* VTL = (LAS bf16*)(c.lds + XA_VT);
    const int r32 = c.lane & 31, hh = c.lane >> 5;
    const size_t qrow = (size_t)b * SEQ + qb * 256 + c.wave * 32 + r32;
    bf16x8 qf[8];
#pragma unroll
    for (int ks = 0; ks < 8; ++ks) qf[ks] = *(const bf16x8*)(Q + qrow * 512 + h * 128 + 16 * ks + 8 * hh);
    f32x16 X[8];
#pragma unroll
    for (int kb = 0; kb < 8; ++kb) { f32x16 acc;
#pragma unroll
        for (int e = 0; e < 16; ++e) acc[e] = 0.f;
#pragma unroll
        for (int ks = 0; ks < 8; ++ks) { const bf16x8 kf = *(const LAS bf16x8*)(KL + (32 * kb + r32) * 136 + 16 * ks + 8 * hh); acc = __builtin_amdgcn_mfma_f32_32x32x16_bf16(kf, qf[ks], acc, 0, 0, 0); }
        X[kb] = acc; }
    float m = -3.0e38f;
#pragma unroll
    for (int kb = 0; kb < 8; ++kb)
#pragma unroll
        for (int e = 0; e < 16; ++e) m = fmax_f(m, X[kb][e]);
    m = fmaxf(m, __shfl_xor(m, 32));
    float rq;
    { const f32x4* sp = (const f32x4*)((const float*)(c.ws + WS_SSQ) + qrow * 16); const f32x4 s0 = sp[0], s1 = sp[1], s2 = sp[2], s3 = sp[3];
      const float tot = ((s0.x + s0.y) + (s0.z + s0.w)) + ((s1.x + s1.y) + (s1.z + s1.w)) + ((s2.x + s2.y) + (s2.z + s2.w)) + ((s3.x + s3.y) + (s3.z + s3.w));
      rq = 1.f / sqrtf(tot * (1.f / 1024.f) + EPS); }
    const float sc = 0.08838834764831845f * 1.4426950408889634f * rq;
    float sum = 0.f;
    const float inv_dummy = 0.f; (void)inv_dummy;
    float inv = 0.f;
#pragma unroll 1
    for (int dh = 0; dh < 2; ++dh) {
        f32x16 OT[2];
#pragma unroll
        for (int db = 0; db < 2; ++db)
#pragma unroll
            for (int e = 0; e < 16; ++e) OT[db][e] = 0.f;
        float psum = 0.f;
#pragma unroll
        for (int kb = 0; kb < 8; ++kb) {
            float p[16];
#pragma unroll
            for (int e = 0; e < 16; ++e) { p[e] = __builtin_amdgcn_exp2f((X[kb][e] - m) * sc); psum += p[e]; }
#pragma unroll
            for (int s = 0; s < 2; ++s) {
                u32x4 pw; pw.x = pk2(p[8 * s + 0], p[8 * s + 1]); pw.y = pk2(p[8 * s + 2], p[8 * s + 3]); pw.z = pk2(p[8 * s + 4], p[8 * s + 5]); pw.w = pk2(p[8 * s + 6], p[8 * s + 7]);
                bf16x8 pf; __builtin_memcpy(&pf, &pw, 16);
#pragma unroll
                for (int db = 0; db < 2; ++db) { const LAS bf16* vr = VTL + (32 * (2 * dh + db) + r32) * 264 + 32 * kb + 16 * s + 4 * hh;
                    const u32x2 v0 = *(const LAS u32x2*)vr, v1 = *(const LAS u32x2*)(vr + 8);
                    const u32x4 vw = {v0.x, v0.y, v1.x, v1.y}; bf16x8 vf; __builtin_memcpy(&vf, &vw, 16);
                    OT[db] = __builtin_amdgcn_mfma_f32_32x32x16_bf16(vf, pf, OT[db], 0, 0, 0); }
            }
        }
        if (dh == 0) { sum = psum + __shfl_xor(psum, 32); inv = 1.f / sum; }
#pragma unroll
        for (int db = 0; db < 2; ++db)
#pragma unroll
            for (int g4 = 0; g4 < 4; ++g4) { u32x2 w; w.x = pk2(OT[db][4 * g4] * inv, OT[db][4 * g4 + 1] * inv); w.y = pk2(OT[db][4 * g4 + 2] * inv, OT[db][4 * g4 + 3] * inv);
                *(u32x2*)(O + qrow * 512 + h * 128 + 32 * (2 * dh + db) + 8 * g4 + 4 * hh) = w; }
    }
}
__device__ __forceinline__ void xattn_pair(const Args& a, const Ctx& c0, int l, int pair) {
    RELAUNDER_CTX(c0);
    const int qb0 = (pair & 7) * 2, h = (pair >> 3) & 3, b = pair >> 5;
    const bf16* KV = (const bf16*)(c.ws + WS_KV) + (size_t)l * MROWS * 1024;
    LAS bf16* KL = (LAS bf16*)(c.lds + XA_K); LAS bf16* VTL = (LAS bf16*)(c.lds + XA_VT);
    __syncthreads();
#pragma unroll
    for (int i = 0; i < 8; ++i) { const int idx = c.tid + NTHR * i, key = idx >> 4, d0 = (idx & 15) * 8; const bf16* src = KV + (size_t)(b * 256 + key) * 1024 + h * 128 + d0;
        *(LAS u32x4*)(KL + key * 136 + d0) = *(const u32x4*)src;
        const u32x4 v = *(const u32x4*)(src + 512);
        VTL[(d0 + 0) * 264 + key] = (bf16)(v.x & 0xffffu); VTL[(d0 + 1) * 264 + key] = (bf16)(v.x >> 16); VTL[(d0 + 2) * 264 + key] = (bf16)(v.y & 0xffffu); VTL[(d0 + 3) * 264 + key] = (bf16)(v.y >> 16);
        VTL[(d0 + 4) * 264 + key] = (bf16)(v.z & 0xffffu); VTL[(d0 + 5) * 264 + key] = (bf16)(v.z >> 16); VTL[(d0 + 6) * 264 + key] = (bf16)(v.w & 0xffffu); VTL[(d0 + 7) * 264 + key] = (bf16)(v.w >> 16); }
    __syncthreads();
    xattn_compute(c, l, b, h, qb0);
    { RELAUNDER_CTX(c0); (void)c; }
    xattn_compute(c, l, b, h, qb0 + 1);
}

constexpr int PH_PER_LAYER = 16, NPHASE = 2 + PH_PER_LAYER * DEPTH + 0;
#ifndef PHMASK
#define PHMASK 0xFFFFFFFFu
#endif
#define PHEN(k) (((PHMASK) >> (k)) & 1u)
#ifndef REPMASK
#define REPMASK 0u
#endif
#define REPN(k) ((((REPMASK) >> (k)) & 1u) ? 2 : 1)
#ifndef ABL_NOCROSS
#define ABL_NOCROSS 0
#endif
#ifndef ABL_NOMOE
#define ABL_NOMOE 0
#endif
#ifndef N_LAUNCHES
#define N_LAUNCHES 1
#endif

__global__ void __launch_bounds__(NTHR, 2) mega_fwd(Args args) {
    extern __shared__ __attribute__((aligned(16))) unsigned char lds_raw[];
#define MKCTX() do { int _tz; { const unsigned _hw = (unsigned)__builtin_amdgcn_s_getreg((5 << 11) | 4) & 63u; const int _wv = __builtin_amdgcn_readfirstlane((int)((volatile LAS unsigned*)(lds_raw + MISC_OFF + 256))[_hw]); \
        unsigned _on = ~0u; asm volatile("" : "+s"(_on)); _tz = _wv * 64 + (int)__builtin_amdgcn_mbcnt_hi(_on, __builtin_amdgcn_mbcnt_lo(_on, 0u)); } asm volatile("" : "+v"(_tz)); unsigned _lz = 0u; asm volatile("" : "+s"(_lz)); int _bz = blockIdx.x; asm volatile("" : "+s"(_bz)); int _gz = gridDim.x; asm volatile("" : "+s"(_gz)); \
        c.lds = (LAS unsigned char*)lds_raw + _lz; c.z = (int)_lz; c.tid = _tz; c.lane = _tz & 63; c.wave = __builtin_amdgcn_readfirstlane(_tz >> 6); c.G = _gz; \
        c.vcu = (_gz % 8 == 0) ? (_bz % 8) * (_gz / 8) + _bz / 8 : _bz; c.gw = c.vcu * NWAVES + c.wave; c.NGW = _gz * NWAVES; bx = _bz; c.bx = _bz; \
        { size_t _wz = 0; asm volatile("" : "+s"(_wz)); ws = args.ws + _wz; } c.ws = ws; HY = (bf16*)(ws + WS_HY); } while (0)
    Ctx c; int bx; unsigned char* ws; bf16* HY;
    { const int t0 = threadIdx.x; volatile LAS unsigned* M0 = (volatile LAS unsigned*)((LAS unsigned char*)lds_raw + MISC_OFF);
      if (t0 < 64) M0[t0] = 0u;
      if ((t0 & 63) == 0) M0[64 + ((unsigned)__builtin_amdgcn_s_getreg((5 << 11) | 4) & 63u)] = (unsigned)(t0 >> 6);
      __syncthreads(); }
    MKCTX();
    volatile LAS unsigned* MISC = (volatile LAS unsigned*)(c.lds + MISC_OFF);
    unsigned* ctl = (unsigned*)(args.ws + WS_CTL);
    XcdBarrier bar = xcd_barrier_post(ctl + CW_BAR, MISC + 8, c.tid);
    const int lo = args.ph_lo, hi = args.ph_hi;
#define IN(k) (lo <= (k) && (k) < hi)
#define SEAM(k) do { if (IN(k) && IN((k) + 1)) xcd_barrier(bar, c.tid); } while (0)

    if (PHEN(0) && IN(0)) { MKCTX();
        for (int job = c.vcu; job < 256; job += c.G) s5_tables_job(args, c, job);
        __syncthreads();
        for (int it = c.gw; it < 2 * NM_ITEMS; it += c.NGW) conv_weights_nm(args, c, it >= NM_ITEMS ? 1 : 0, it >= NM_ITEMS ? it - NM_ITEMS : it);
        memn_phase(args, c);
        norm_phase<0, false>(args, c, args.in[I_NORM_MIX + c.z]);
#ifdef REP_P0
        __syncthreads();
        for (int job = c.vcu; job < 256; job += c.G) s5_tables_job(args, c, job);
        __syncthreads();
        for (int it = c.gw; it < 2 * NM_ITEMS; it += c.NGW) conv_weights_nm(args, c, it >= NM_ITEMS ? 1 : 0, it >= NM_ITEMS ? it - NM_ITEMS : it);
        memn_phase(args, c);
        norm_phase<0, false>(args, c, args.in[I_NORM_MIX + c.z]);
#endif
    }
    SEAM(0);
#ifdef REP_BARRIERS
    for (int rb_ = 0; rb_ < 32; ++rb_) xcd_barrier(bar, c.tid);
#endif
    for (int l = 0; l < DEPTH; ++l) {
        const int pb = 2 + PH_PER_LAYER * l;
        if (PHEN(2) && IN(pb + 0)) { MKCTX();
            if (l == 0) {
#pragma unroll 1
                for (int lk = 0; lk < DEPTH; ++lk) { const int ck = bx - 128 - 32 * lk;
                    pg8::Sched2D Sk{(const char*)(ws + WS_MEMN), (const char*)(ws + WS_WNM + (size_t)lk * WN_LAYER + WN_CKV), (size_t)256 * 1024 * 2, (size_t)256 * 1024 * 2, MROWS / 256, 4, c.G, (ck >= 0 && ck < 32) ? ck : 1 << 20};
                    pg8::EpiBf16 Ek{(bf16*)(ws + WS_KV) + (size_t)lk * MROWS * 1024, 1024};
                    pg8::gemm_phase(c.lds, c.tid, Sk, Ek, 1024, 1024, 1024); }
            }
        }
        if (PHEN(2) && IN(pb + 0)) { MKCTX();
            pg8::Sched2DSplit S8{(const char*)(ws + WS_H8), (const char*)(ws + WS_WNM + (size_t)l * WN_LAYER + WN_IN + (size_t)NPROJ * 1024 * 2), (size_t)256 * 1024, (size_t)256 * 1024, T / 256, NGATE / 256, c.G, bx, l == 0 ? 8 : 7};
            pg8::EpiGate8 E8{ws + WS_GATES};
            pg8::gemm_phase(c.lds, c.tid, S8, E8, 512, 512, 512);
#ifdef REP_G8
            pg8::gemm_phase(c.lds, c.tid, S8, E8, 512, 512, 512);
#endif
        }
        if (PHEN(2) && IN(pb + 0)) { MKCTX();
            pg8::Sched2D S{(const char*)HY, (const char*)(ws + WS_WNM + (size_t)l * WN_LAYER + WN_IN), (size_t)256 * 1024 * 2, (size_t)256 * 1024 * 2, T / 256, NPROJ / 256, c.G, bx};
            pg8::EpiInProj E{(bf16*)(ws + WS_PROJ), ws + WS_GATES};
            pg8::gemm_phase(c.lds, c.tid, S, E, 1024, 1024, 1024);
        }
        SEAM(pb + 0);
        if (PHEN(3) && IN(pb + 1)) { MKCTX();
            token_prep_phase(args, c, l);
            gla_tasks<1>(args, c, l);
            for (int u = bx; u < 256; u += c.G) s5_1_unit(args, c, l, u);
#ifdef REP_GLA1
            __syncthreads();
            gla_tasks<1>(args, c, l);
#endif
#ifdef REP_S51
            __syncthreads();
            for (int u = bx; u < 256; u += c.G) s5_1_unit(args, c, l, u);
#endif
        }
        SEAM(pb + 1);
        if (PHEN(4) && IN(pb + 2)) { MKCTX();
            gla2_phase(args, c);
            s5_2_phase(args, c, l);
#ifdef REP_DSA_NOATT
            dsa_phase<0>(args, c, l);
#endif
#ifdef REP_DSA_NOSC
            dsa_phase<3>(args, c, l);
#endif
#ifdef REP_DSA_FIXK
            dsa_phase<2>(args, c, l);
#endif
#ifdef REP_DSA
            dsa_phase<1>(args, c, l);
#endif
            dsa_phase<1>(args, c, l);
        }
        SEAM(pb + 2);
        if (PHEN(5) && IN(pb + 3)) { MKCTX();
            gla_tasks<3>(args, c, l);
            for (int u = bx; u < 256; u += c.G) s5_3_unit(args, c, l, u);
#ifdef REP_GLA3
            __syncthreads();
            gla_tasks<3>(args, c, l);
#endif
#ifdef REP_S53
            __syncthreads();
            for (int u = bx; u < 256; u += c.G) s5_3_unit(args, c, l, u);
#endif
        }
        SEAM(pb + 3);
        if (PHEN(6) && IN(pb + 4)) { MKCTX();
            pg8::Sched2D S{(const char*)(ws + WS_YPRE), (const char*)(ws + WS_WNM + (size_t)l * WN_LAYER + WN_GLU), (size_t)256 * 256 * 2, (size_t)256 * 256 * 2, T / 256, 1, c.G, bx};
            pg8::EpiGlu E{(const bf16*)(ws + WS_YPRE), args.in[I_S5_BGLU + c.z] + (size_t)l * 256, HY};
            pg8::gemm_phase(c.lds, c.tid, S, E, 256, 256, 256);
            if (REPN(6) == 2) { pg8::gemm_phase(c.lds, c.tid, S, E, 256, 256, 256); }
        }
        SEAM(pb + 4);
        if (PHEN(7) && IN(pb + 5)) { MKCTX();
            pg8::SchedBranch S{(const char*)HY, (const char*)(ws + WS_WNM + (size_t)l * WN_LAYER + WN_BR), T / 256, 4, c.G, bx};
            pg8::EpiBranch E{ws + WS_GATES, (bf16*)(ws + WS_MERGED)};
            pg8::gemm_phase(c.lds, c.tid, S, E, 256, 1024, 1024);
            if (REPN(7) == 2) { pg8::gemm_phase(c.lds, c.tid, S, E, 256, 1024, 1024); }
        }
        SEAM(pb + 5);
        if (PHEN(8) && IN(pb + 6)) { MKCTX();
            pg8::Sched2D S{(const char*)(ws + WS_MERGED), (const char*)(ws + WS_WNM + (size_t)l * WN_LAYER + WN_OUT), (size_t)256 * 1024 * 2, (size_t)256 * 1024 * 2, T / 256, 4, c.G, bx};
            pg8::EpiResidX E{args.out, HY, (float*)(ws + WS_SSQ), l == 0 ? args.in[I_X + c.z] : (const float*)args.out};
            pg8::gemm_phase(c.lds, c.tid, S, E, 1024, 1024, 1024);
        }
        SEAM(pb + 6);
        if (PHEN(10) && IN(pb + 8)) { MKCTX();
            pg8::Sched2D S{(const char*)HY, (const char*)(ws + WS_WNM + (size_t)l * WN_LAYER + WN_CQ), (size_t)256 * 1024 * 2, (size_t)256 * 1024 * 2, T / 256, 2, c.G, bx};
            pg8::EpiBf16 E{(bf16*)(ws + WS_Q), 512};
            pg8::gemm_phase(c.lds, c.tid, S, E, 1024, 1024, 1024);
            if (REPN(10) == 2) { pg8::gemm_phase(c.lds, c.tid, S, E, 1024, 1024, 1024); }
        }
        SEAM(pb + 8);
        if (PHEN(11) && IN(pb + 9)) { MKCTX(); for (int u = bx; u < 256; u += c.G) xattn_pair(args, c, l, u);
#ifdef REP_XATTN
            for (int u = bx; u < 256; u += c.G) xattn_pair(args, c, l, u);
#endif
        }
        SEAM(pb + 9);
        if (PHEN(12) && IN(pb + 10) && !ABL_NOCROSS) { MKCTX();
            pg8::Sched2D S{(const char*)(ws + WS_O), (const char*)(ws + WS_WNM + (size_t)l * WN_LAYER + WN_CO), (size_t)256 * 512 * 2, (size_t)256 * 512 * 2, T / 256, 4, c.G, bx};
            pg8::EpiResid E{args.out};
            pg8::gemm_phase(c.lds, c.tid, S, E, 512, 512, 512);
        }
        SEAM(pb + 10);
        if (PHEN(13) && IN(pb + 11)) { MKCTX();
            ffn_norm_route_phase(args, c, l);
            __syncthreads();
            for (int it = c.gw; it < MOE_ITEMS; it += c.NGW) conv_weights_moe(args, c, l, it);
        }
        SEAM(pb + 11);
        if (PHEN(15) && IN(pb + 13)) { MKCTX();
            LAS int* tb = (LAS int*)(c.lds + 140000); moe_tables(c, l, tb);
            pg8::SchedMoe<true> S{(const char*)(ws + WS_H8F), (const char*)(ws + WS_WMOE + WM_GU), (size_t)0, (size_t)1024 * 1024, (size_t)256 * 1024, tb, (const int*)(ws + WS_ROWMAP), 4, c.G, bx};
            pg8::EpiGateUp8 E{ws + WS_HE};
            pg8::gemm_phase(c.lds, c.tid, S, E, 512, 512, 512);
        }
        SEAM(pb + 13);
        if (PHEN(16) && IN(pb + 14)) { MKCTX();
            LAS int* tb = (LAS int*)(c.lds + 140000); moe_tables(c, l, tb);
            pg8::SchedMoe<false> S{(const char*)(ws + WS_HE), (const char*)(ws + WS_WMOE + WM_DN), (size_t)256 * 512, (size_t)1024 * 512, (size_t)256 * 512, tb, (const int*)(ws + WS_ROWMAP), 4, c.G, bx};
            pg8::EpiBf16S8 E{(bf16*)(ws + WS_OB), 1024, 1.f / 512.f};
            pg8::gemm_phase(c.lds, c.tid, S, E, 256, 256, 256);
        }
        SEAM(pb + 14);
        if (PHEN(17) && IN(pb + 15)) { MKCTX();
            if (l + 1 < DEPTH) norm_phase<ABL_NOMOE ? 1 : 2, false>(args, c, args.in[I_NORM_MIX + c.z] + (size_t)(l + 1) * 1024, l);
            else norm_phase<ABL_NOMOE ? 1 : 2, true>(args, c, args.in[I_NORM_FINAL + c.z], l);
        }
        SEAM(pb + 15);
    }
#undef IN
#undef SEAM
}

extern "C" void kernel_launch(void* const* d_in, const int* in_sizes, int n_in, void* d_out, int out_size, void* d_ws, size_t ws_size, hipStream_t stream) {
    static int grid = 0;
    if (grid == 0) {
        if (n_in != 36 || out_size != T * D || ws_size < WS_END) { fprintf(stderr, "kernel_launch: unexpected shapes: n_in %d out %d ws %zu (need %zu)\n", n_in, out_size, ws_size, (size_t)WS_END); grid = -1; return; }
        int dev = 0, cus = 0, per_cu = 0;
        if (hipGetDevice(&dev) != hipSuccess || hipDeviceGetAttribute(&cus, hipDeviceAttributeMultiprocessorCount, dev) != hipSuccess) { grid = -1; return; }
        if (hipFuncSetAttribute((const void*)mega_fwd, hipFuncAttributeMaxDynamicSharedMemorySize, LDS_BYTES) != hipSuccess) { fprintf(stderr, "kernel_launch: hipFuncSetAttribute failed\n"); grid = -1; return; }
        if (hipOccupancyMaxActiveBlocksPerMultiprocessor(&per_cu, (const void*)mega_fwd, NTHR, LDS_BYTES) != hipSuccess || per_cu < 1) fprintf(stderr, "kernel_launch: occupancy query reports %d\n", per_cu);
        (void)hipGetLastError();
        grid = cus;
        if (grid != 256) fprintf(stderr, "kernel_launch: %d CUs (built for 256)\n", grid);
    }
    if (grid < 0) return;
    if (hipMemsetAsync((char*)d_ws + WS_CTL, 0, CTL_ZERO_BYTES, stream) != hipSuccess) return;
    Args a{};
    for (int i = 0; i < 36; ++i) a.in[i] = (const float*)d_in[i];
    a.out = (float*)d_out; a.ws = (unsigned char*)d_ws;
#if N_LAUNCHES == 1
    a.ph_lo = 0; a.ph_hi = NPHASE;
    hipLaunchKernelGGL(mega_fwd, dim3(grid), dim3(NTHR), LDS_BYTES, stream, a);
#else
    for (int p = 0; p < NPHASE; ++p) { a.ph_lo = p; a.ph_hi = p + 1; hipLaunchKernelGGL(mega_fwd, dim3(grid), dim3(NTHR), LDS_BYTES, stream, a); }
#endif
}
```
